# Optimizing an MI355X kernel written in HIP

```python
import math
import jax, jax.numpy as jnp
from jax import lax
import numpy as np

D_MODEL = 1024
BATCH = 8
SEQ = 4096
DEPTH = 4

GRID_W = 64
CTX_LEN = 256
N_MIXERS = 3
HEAD_DIM = 64
MIX_WIDTH = D_MODEL
A_HEADS = 16
A_KV_HEADS = 4
A_GROUP = A_HEADS // A_KV_HEADS
A_IN = A_HEADS * HEAD_DIM + 2 * A_KV_HEADS * HEAD_DIM + MIX_WIDTH
B_HEADS = MIX_WIDTH // HEAD_DIM
WIN_H = 8
WIN_W = 16
B_IN = 3 * B_HEADS * HEAD_DIM + MIX_WIDTH
C_HEADS = MIX_WIDTH // (2 * HEAD_DIM)
C_V_DIM = 2 * HEAD_DIM
C_IN = 2 * C_HEADS * 2 * HEAD_DIM + C_HEADS * C_V_DIM + MIX_WIDTH
N_A = (DEPTH + 2) // 3
N_B = (DEPTH + 1) // 3
N_C = DEPTH // 3
Q_BLOCK = 128
QB_ROWS = Q_BLOCK // GRID_W
ROPE_BASE = 10000.0
EPS = 1e-6
NEG_INF = -1e30

kernel_name = "hybrid_dit_interleaved_gqa_na_diff"


def rms_norm(x, g):
    xf = x.astype(jnp.float32)
    y = xf * lax.rsqrt(jnp.mean(xf * xf, axis=-1, keepdims=True) + EPS)
    return (y * g.astype(jnp.float32)).astype(x.dtype)


def lambda_init_fn(layer):
    return 0.8 - 0.6 * math.exp(-0.3 * layer)


def axial_rope_angles(n_tokens):
    t = jnp.arange(n_tokens, dtype=jnp.int32)
    rows = (t // GRID_W).astype(jnp.float32)
    cols = (t % GRID_W).astype(jnp.float32)
    n_freq = HEAD_DIM // 4
    inv_freq = ROPE_BASE ** (-jnp.arange(n_freq, dtype=jnp.float32) / n_freq)
    return rows[:, None] * inv_freq, cols[:, None] * inv_freq


def _rotate(x, ang):
    x1, x2 = jnp.split(x, 2, axis=-1)
    shape = (1, ang.shape[0]) + (1,) * (x.ndim - 3) + (ang.shape[1],)
    cos = jnp.cos(ang).reshape(shape).astype(x.dtype)
    sin = jnp.sin(ang).reshape(shape).astype(x.dtype)
    return jnp.concatenate([x1 * cos - x2 * sin, x2 * cos + x1 * sin], axis=-1)


def axial_rope(x, ang):
    ang_r, ang_c = ang
    x_r, x_c = jnp.split(x, 2, axis=-1)
    return jnp.concatenate([_rotate(x_r, ang_r), _rotate(x_c, ang_c)], axis=-1)


def map_query_blocks(block_fn, q):
    b, s = q.shape[:2]
    n_blk = s // Q_BLOCK
    qb = q.reshape((b, n_blk, Q_BLOCK) + q.shape[2:]).swapaxes(0, 1)
    out = lax.map(lambda args: block_fn(*args), (jnp.arange(n_blk, dtype=jnp.int32), qb))
    return out.swapaxes(0, 1).reshape((b, s) + out.shape[3:])


def gqa_attention(q, k, v):
    scale = HEAD_DIM ** -0.5

    def block(j, qb):
        logits = jnp.einsum("bqhgd,bkhd->bhgqk", qb, k).astype(jnp.float32) * scale
        p = jax.nn.softmax(logits, axis=-1).astype(v.dtype)
        return jnp.einsum("bhgqk,bkhd->bqhgd", p, v)

    return map_query_blocks(block, q)


def neighbourhood_attention(q, k, v, kc, vc, rpb, rows):
    b, s, h, d = q.shape
    kh = min(WIN_H, rows)
    kb = min(kh + QB_ROWS - 1, rows)
    scale = HEAD_DIM ** -0.5
    k_grid = k.reshape(b, rows, GRID_W, h, d)
    v_grid = v.reshape(b, rows, GRID_W, h, d)
    col = jnp.arange(GRID_W, dtype=jnp.int32)
    col_start = jnp.clip(col - WIN_W // 2, 0, GRID_W - WIN_W)
    q_col = jnp.tile(col, QB_ROWS)[:, None]
    q_cs = jnp.tile(col_start, QB_ROWS)[:, None]
    k_col = jnp.tile(col, kb)[None, :]

    def block(j, qb):
        q_rows = j * QB_ROWS + jnp.arange(QB_ROWS, dtype=jnp.int32)
        row_start = jnp.clip(q_rows - kh // 2, 0, rows - kh)
        band = jnp.clip(row_start[0], 0, rows - kb)
        k_band = lax.dynamic_slice_in_dim(k_grid, band, kb, axis=1).reshape(b, kb * GRID_W, h, d)
        v_band = lax.dynamic_slice_in_dim(v_grid, band, kb, axis=1).reshape(b, kb * GRID_W, h, d)
        q_row = jnp.repeat(q_rows, GRID_W)[:, None]
        q_rs = jnp.repeat(row_start, GRID_W)[:, None]
        k_row = (band + jnp.repeat(jnp.arange(kb, dtype=jnp.int32), GRID_W))[None, :]
        in_window = ((k_row >= q_rs) & (k_row < q_rs + kh)
                     & (k_col >= q_cs) & (k_col < q_cs + WIN_W))
        d_row = jnp.clip(k_row - q_row + WIN_H - 1, 0, 2 * WIN_H - 2)
        d_col = jnp.clip(k_col - q_col + WIN_W - 1, 0, 2 * WIN_W - 2)
        bias = rpb[:, d_row, d_col].astype(jnp.float32)
        logit_lat = jnp.einsum("bqhd,bkhd->bhqk", qb, k_band).astype(jnp.float32) * scale + bias
        logit_lat = jnp.where(in_window, logit_lat, NEG_INF)
        logit_ctx = jnp.einsum("bqhd,bkhd->bhqk", qb, kc).astype(jnp.float32) * scale
        p = jax.nn.softmax(jnp.concatenate([logit_ctx, logit_lat], axis=-1), axis=-1).astype(v.dtype)
        return jnp.einsum("bhqk,bkhd->bqhd", p, jnp.concatenate([vc, v_band], axis=1))

    return map_query_blocks(block, q)


def diff_attention(q, k, v, lam):
    scale = HEAD_DIM ** -0.5

    def block(j, qb):
        logits = jnp.einsum("bqhmd,bkhmd->bhmqk", qb, k).astype(jnp.float32) * scale
        p = jax.nn.softmax(logits, axis=-1)
        a = (p[:, :, 0] - lam * p[:, :, 1]).astype(v.dtype)
        return jnp.einsum("bhqk,bkhd->bqhd", a, v)

    return map_query_blocks(block, q)


def mixer_a(u, uc, q_g, k_g, ang, need_ctx):
    b, s, _ = u.shape
    n_ctx = uc.shape[1]
    q_dim, kv_dim = A_HEADS * HEAD_DIM, A_KV_HEADS * HEAD_DIM

    def heads(t):
        n = t.shape[1]
        q, k, v = jnp.split(t, [q_dim, q_dim + kv_dim], axis=-1)
        q = rms_norm(q.reshape(b, n, A_KV_HEADS, A_GROUP, HEAD_DIM), q_g)
        k = rms_norm(k.reshape(b, n, A_KV_HEADS, HEAD_DIM), k_g)
        return q, k, v.reshape(b, n, A_KV_HEADS, HEAD_DIM)

    q, k, v = heads(u)
    qc, kc, vc = heads(uc)
    q, k = axial_rope(q, ang), axial_rope(k, ang)
    o = gqa_attention(q, jnp.concatenate([kc, k], axis=1),
                      jnp.concatenate([vc, v], axis=1)).reshape(b, s, MIX_WIDTH)
    oc = gqa_attention(qc, kc, vc).reshape(b, n_ctx, MIX_WIDTH) if need_ctx else None
    return o, oc


def mixer_b(u, uc, q_g, k_g, rpb, rows, need_ctx):
    b, s, _ = u.shape
    n_ctx = uc.shape[1]

    def heads(t):
        n = t.shape[1]
        q, k, v = jnp.split(t, 3, axis=-1)
        shp = (b, n, B_HEADS, HEAD_DIM)
        return rms_norm(q.reshape(shp), q_g), rms_norm(k.reshape(shp), k_g), v.reshape(shp)

    q, k, v = heads(u)
    qc, kc, vc = heads(uc)
    o = neighbourhood_attention(q, k, v, kc, vc, rpb, rows).reshape(b, s, MIX_WIDTH)
    oc = gqa_attention(qc[:, :, :, None], kc, vc).reshape(b, n_ctx, MIX_WIDTH) if need_ctx else None
    return o, oc


def mixer_c(u, uc, q_g, k_g, lq1, lk1, lq2, lk2, subln_g, lambda_init, ang, need_ctx):
    b, s, _ = u.shape
    n_ctx = uc.shape[1]
    qk_dim = C_HEADS * 2 * HEAD_DIM

    def heads(t):
        n = t.shape[1]
        q, k, v = jnp.split(t, [qk_dim, 2 * qk_dim], axis=-1)
        shp = (b, n, C_HEADS, 2, HEAD_DIM)
        return (rms_norm(q.reshape(shp), q_g), rms_norm(k.reshape(shp), k_g),
                v.reshape(b, n, C_HEADS, C_V_DIM))

    q, k, v = heads(u)
    qc, kc, vc = heads(uc)
    q, k = axial_rope(q, ang), axial_rope(k, ang)
    f32 = jnp.float32
    lam = (jnp.exp(jnp.sum(lq1.astype(f32) * lk1.astype(f32)))
           - jnp.exp(jnp.sum(lq2.astype(f32) * lk2.astype(f32))) + lambda_init)

    def finish(o, n):
        return (rms_norm(o, subln_g) * (1.0 - lambda_init)).reshape(b, n, MIX_WIDTH)

    o = finish(diff_attention(q, jnp.concatenate([kc, k], axis=1),
                              jnp.concatenate([vc, v], axis=1), lam), s)
    oc = finish(diff_attention(qc, kc, vc, lam), n_ctx) if need_ctx else None
    return o, oc


def setup_inputs(seed: int = 0) -> dict:
    key = jax.random.key(seed)
    ks = jax.random.split(key, 28)
    f32 = jnp.float32

    def nrm(k, shape, scale):
        return jax.random.normal(k, shape, f32) * scale

    def gain(k, shape):
        return 1.0 + 0.02 * jax.random.normal(k, shape, f32)

    d_in = D_MODEL ** -0.5
    d_mix = MIX_WIDTH ** -0.5
    return {
        "x": nrm(ks[0], (BATCH, SEQ, D_MODEL), 1.0),
        "c": nrm(ks[1], (BATCH, D_MODEL), 1.0),
        "ctx": nrm(ks[2], (BATCH, CTX_LEN, D_MODEL), 1.0),
        "c_ctx": nrm(ks[3], (D_MODEL,), 1.0),
        "norm_g": gain(ks[4], (DEPTH, D_MODEL)),
        "ada_w": nrm(ks[5], (DEPTH, D_MODEL, 3 * D_MODEL), 0.5 * d_in),
        "ada_b": nrm(ks[6], (DEPTH, 3 * D_MODEL), 0.01),
        "a_w_in": nrm(ks[7], (N_A, D_MODEL, A_IN), d_in),
        "a_q_g": gain(ks[8], (N_A, HEAD_DIM)),
        "a_k_g": gain(ks[9], (N_A, HEAD_DIM)),
        "a_w_out": nrm(ks[10], (N_A, MIX_WIDTH, D_MODEL), d_mix),
        "b_w_in": nrm(ks[11], (N_B, D_MODEL, B_IN), d_in),
        "b_q_g": gain(ks[12], (N_B, HEAD_DIM)),
        "b_k_g": gain(ks[13], (N_B, HEAD_DIM)),
        "b_rpb": nrm(ks[14], (N_B, B_HEADS, 2 * WIN_H - 1, 2 * WIN_W - 1), 0.1),
        "b_w_out": nrm(ks[15], (N_B, MIX_WIDTH, D_MODEL), d_mix),
        "c_w_in": nrm(ks[16], (N_C, D_MODEL, C_IN), d_in),
        "c_q_g": gain(ks[17], (N_C, HEAD_DIM)),
        "c_k_g": gain(ks[18], (N_C, HEAD_DIM)),
        "c_lam_q1": nrm(ks[19], (N_C, HEAD_DIM), 0.1),
        "c_lam_k1": nrm(ks[20], (N_C, HEAD_DIM), 0.1),
        "c_lam_q2": nrm(ks[21], (N_C, HEAD_DIM), 0.1),
        "c_lam_k2": nrm(ks[22], (N_C, HEAD_DIM), 0.1),
        "c_subln_g": gain(ks[23], (N_C, C_V_DIM)),
        "c_w_out": nrm(ks[24], (N_C, MIX_WIDTH, D_MODEL), d_mix),
    }


def reference(x, c, ctx, c_ctx, norm_g, ada_w, ada_b,
              a_w_in, a_q_g, a_k_g, a_w_out,
              b_w_in, b_q_g, b_k_g, b_rpb, b_w_out,
              c_w_in, c_q_g, c_k_g, c_lam_q1, c_lam_k1, c_lam_q2, c_lam_k2, c_subln_g, c_w_out):
    s = x.shape[1]
    rows = s // GRID_W
    ang = axial_rope_angles(s)
    xc = ctx
    for i in range(DEPTH):
        kind, j = i % N_MIXERS, i // N_MIXERS
        need_ctx = i < DEPTH - 1
        sh, sc, gt = jnp.split(jax.nn.silu(c) @ ada_w[i] + ada_b[i], 3, axis=-1)
        shc, scc, gtc = jnp.split(jax.nn.silu(c_ctx) @ ada_w[i] + ada_b[i], 3, axis=-1)
        h = rms_norm(x, norm_g[i]) * (1.0 + sc[:, None]) + sh[:, None]
        hc = rms_norm(xc, norm_g[i]) * (1.0 + scc) + shc
        w_in = (a_w_in, b_w_in, c_w_in)[kind][j]
        w_out = (a_w_out, b_w_out, c_w_out)[kind][j]
        n_mix_cols = w_in.shape[1] - MIX_WIDTH
        u, z = jnp.split(h @ w_in, [n_mix_cols], axis=-1)
        if need_ctx:
            uc, zc = jnp.split(hc @ w_in, [n_mix_cols], axis=-1)
        else:
            uc = hc @ w_in[:, :n_mix_cols]
        if kind == 0:
            o, oc = mixer_a(u, uc, a_q_g[j], a_k_g[j], ang, need_ctx)
        elif kind == 1:
            o, oc = mixer_b(u, uc, b_q_g[j], b_k_g[j], b_rpb[j], rows, need_ctx)
        else:
            o, oc = mixer_c(u, uc, c_q_g[j], c_k_g[j], c_lam_q1[j], c_lam_k1[j],
                            c_lam_q2[j], c_lam_k2[j], c_subln_g[j], lambda_init_fn(i), ang, need_ctx)
        x = x + gt[:, None] * ((o * jax.nn.silu(z)) @ w_out)
        if need_ctx:
            xc = xc + gtc * ((oc * jax.nn.silu(zc)) @ w_out)
    return x
```

```cpp
#include <hip/hip_runtime.h>
#include <hip/hip_cooperative_groups.h>
#include <cstdio>
#include <cmath>
namespace cg = cooperative_groups;

typedef unsigned short bf16_t;
constexpr float LOG2E_ = 1.4426950408889634f;
typedef short bf16x8 __attribute__((ext_vector_type(8)));
typedef float f32x16 __attribute__((ext_vector_type(16)));
typedef float f32x4 __attribute__((ext_vector_type(4)));
typedef unsigned u32x4 __attribute__((ext_vector_type(4)));
typedef unsigned u32x2 __attribute__((ext_vector_type(2)));
#define LAS __attribute__((address_space(3)))

#define MFMA32(a, b, c) __builtin_amdgcn_mfma_f32_32x32x16_bf16((a), (b), (c), 0, 0, 0)

constexpr int D = 1024, NB = 8, SEQ = 4096, CTXL = 256, TT = SEQ + CTXL;
constexpr int MLAT = NB * SEQ, MCTX = NB * CTXL, MTOT = MLAT + MCTX;
constexpr int LDT = 72;
constexpr int NTHR = 512;
constexpr int LDS_BYTES = 158208;
constexpr float LOG2E = 1.4426950408889634f;
constexpr float QSCALE = 0.125f * LOG2E;
constexpr float EPS = 1e-6f;

__constant__ float INVF[16] = {1.0f, 0.5623413324356079f, 0.3162277638912201f, 0.17782793939113617f, 0.10000000149011612f,
    0.05623413249850273f, 0.03162277489900589f, 0.017782794311642647f, 0.009999999776482582f, 0.005623413249850273f,
    0.003162277629598975f, 0.0017782794311642647f, 0.0010000000474974513f, 0.000562341301701963f, 0.0003162277571391314f,
    0.00017782794020604342f};

struct Params {
    const float *x, *c, *ctx, *c_ctx, *norm_g, *ada_w, *ada_b;
    const float* w_in[4]; const float* w_out[4]; const float* q_g[4]; const float* k_g[4];
    const float *rpb, *lq1, *lk1, *lq2, *lk2, *subln_g;
    float* out;
    float* xb;
    bf16_t *h, *q, *k, *vt, *sz, *og;
    bf16_t* wt_in[4]; bf16_t* wt_out[4];
    float *mod, *rope, *lam, *scr;
    unsigned* bar;
    float lam_init; float pad0;
};

__device__ __forceinline__ unsigned pk_bf16(float lo, float hi) {
    unsigned r; asm("v_cvt_pk_bf16_f32 %0, %1, %2" : "=v"(r) : "v"(lo), "v"(hi)); return r;
}
__device__ __forceinline__ int swap23(int x) { return (x & 0x13) | ((x & 4) << 1) | ((x & 8) >> 1); }
__device__ __forceinline__ float fast_exp2(float x) { return __builtin_amdgcn_exp2f(x); }
__device__ __forceinline__ float wave_sum64(float v) {
    v += __uint_as_float(__builtin_amdgcn_mov_dpp(__float_as_uint(v), 0xB1, 0xF, 0xF, true));
    v += __uint_as_float(__builtin_amdgcn_mov_dpp(__float_as_uint(v), 0x4E, 0xF, 0xF, true));
    v += __uint_as_float(__builtin_amdgcn_mov_dpp(__float_as_uint(v), 0x141, 0xF, 0xF, true));
    v += __uint_as_float(__builtin_amdgcn_mov_dpp(__float_as_uint(v), 0x140, 0xF, 0xF, true));
    { auto rr = __builtin_amdgcn_permlane16_swap(__float_as_uint(v), __float_as_uint(v), false, false); v = __uint_as_float(rr[0]) + __uint_as_float(rr[1]); }
    { auto rr = __builtin_amdgcn_permlane32_swap(__float_as_uint(v), __float_as_uint(v), false, false); v = __uint_as_float(rr[0]) + __uint_as_float(rr[1]); }
    return v;
}
__device__ __forceinline__ float silu_f(float z) { return z * __builtin_amdgcn_rcpf(1.0f + __builtin_amdgcn_exp2f(-LOG2E_ * z)); }
template <typename T> __device__ __forceinline__ T sel4(T const (&a)[4], int l) { return l == 0 ? a[0] : (l == 1 ? a[1] : (l == 2 ? a[2] : a[3])); }
__host__ __device__ __forceinline__ int layer_N(int l) { return (l == 0 || l == 3) ? 2560 : 4096; }

namespace pg8 {
constexpr int BM = 256, BK = 64, HALF = 128, HTB = HALF * BK * 2, STAGE_BYTES = 8 * HTB;
__device__ __forceinline__ int lds_byte(int r, int c) { const int st = (r >> 4) * 2 + (c >> 5), rr = r & 15, cc = c & 31, ob = rr * 64 + cc * 2; return st * 1024 + (ob ^ (((ob >> 9) & 1) << 5)); }
__device__ __forceinline__ void stage_rc(int b, int& R, int& C) { const int st = b / 1024, sb = b % 1024, swz = sb ^ (((sb >> 9) & 1) << 5); R = (st >> 1) * 16 + swz / 64; C = (st & 1) * 32 + (swz % 64) / 2; }

struct Unit { const char* a; const char* b; int pm, pn, kind; };

template <class Epi, class Sched>
__device__ __forceinline__ void gemm_phase(LAS unsigned char* lds, const int K, const Sched& S, const Epi& E) {
    int tid = threadIdx.x; asm volatile("" : "+v"(tid));
    const int wid = __builtin_amdgcn_readfirstlane(tid >> 6), lane = tid & 63, wr = wid >> 2, wc = wid & 3, fr = lane & 15, fq = lane >> 4;
    const int nt = K / BK;
    unsigned voffA[2];
#pragma unroll
    for (int i = 0; i < 2; ++i) { int R, C; stage_rc(tid * 16 + i * 8192, R, C); voffA[i] = (unsigned)(R * K + C) * 2u; }
    const size_t kstep = (size_t)(BK * 2);
    const size_t hstep = (size_t)HALF * K * 2;
    const unsigned ldsw = (unsigned)wid * 1024u;
    const int aoff = lds_byte(wr * 64 + fr, fq * 8), boff = lds_byte(wc * 32 + fr, fq * 8);
#define PG8_SA(b, h) (((b) * 2 + (h)) * HTB)
#define PG8_SB(b, h) ((4 + (b) * 2 + (h)) * HTB)
#define PG8_STAGE(bufoff, gbase, voff) do { _Pragma("unroll") for (int _i = 0; _i < 2; ++_i) \
        __builtin_amdgcn_global_load_lds((const unsigned*)((const char*)(gbase) + (voff)[_i]), (LAS unsigned*)(lds + (bufoff) + ldsw + _i * 8192), 16, 0, 0); } while (0)
#define PG8_LDA(dst, b, h) do { _Pragma("unroll") for (int m = 0; m < 4; ++m) _Pragma("unroll") for (int k = 0; k < 2; ++k) dst[m][k] = *(const LAS bf16x8*)(lds + PG8_SA(b, h) + aoff + m * 2048 + k * 1024); } while (0)
#define PG8_LDB(dst, b, h) do { _Pragma("unroll") for (int n = 0; n < 2; ++n) _Pragma("unroll") for (int k = 0; k < 2; ++k) dst[n][k] = *(const LAS bf16x8*)(lds + PG8_SB(b, h) + boff + n * 2048 + k * 1024); } while (0)
#define PG8_MMA(ai, bj, At, Bt) do { __builtin_amdgcn_s_setprio(1); _Pragma("unroll") for (int m = 0; m < 4; ++m) _Pragma("unroll") for (int n = 0; n < 2; ++n) _Pragma("unroll") for (int k = 0; k < 2; ++k) \
        acc[ai][bj][m][n] = __builtin_amdgcn_mfma_f32_16x16x32_bf16(Bt[n][k], At[m][k], acc[ai][bj][m][n], 0, 0, 0); __builtin_amdgcn_s_setprio(0); } while (0)
#define PG8_WAIT_V(n) asm volatile("s_waitcnt vmcnt(" #n ")" ::: "memory")
#define PG8_WAIT_L(n) asm volatile("s_waitcnt lgkmcnt(" #n ")" ::: "memory")
#define PG8_BAR __builtin_amdgcn_s_barrier()
#define PG8_SCHED __builtin_amdgcn_sched_barrier(0)
    Unit cur, nxt; int ui = 0;
    if (!S.next(0, cur)) return;
    f32x4 acc[2][2][4][2];
#pragma unroll
    for (int a = 0; a < 2; ++a)
#pragma unroll
        for (int b = 0; b < 2; ++b)
#pragma unroll
            for (int m = 0; m < 4; ++m)
#pragma unroll
                for (int n = 0; n < 2; ++n) acc[a][b][m][n] = (f32x4){0.f, 0.f, 0.f, 0.f};
    bf16x8 At[4][2], B0[2][2], B1[2][2];
    const char* cA = cur.a; const char* cB = cur.b;
    {
        PG8_STAGE(PG8_SB(0, 0), cB, voffA); PG8_STAGE(PG8_SB(0, 1), cB + hstep, voffA); PG8_STAGE(PG8_SA(0, 0), cA, voffA); PG8_STAGE(PG8_SA(0, 1), cA + hstep, voffA);
        if (wr == 1) PG8_BAR;
        PG8_WAIT_V(2); PG8_BAR;
        PG8_STAGE(PG8_SB(1, 0), cB + kstep, voffA); PG8_STAGE(PG8_SA(1, 0), cA + kstep, voffA); PG8_STAGE(PG8_SB(1, 1), cB + hstep + kstep, voffA);
        PG8_WAIT_V(6); PG8_BAR;
    }
    for (;;) {
        const bool has_next = S.next(ui + 1, nxt);
        const char* nA = has_next ? nxt.a : cA; const char* nB = has_next ? nxt.b : cB;
        for (int t = 0; t < nt; t += 2) {
            const bool last = (t == nt - 2);
            const char* a1 = cA + (size_t)(t + 1) * kstep;
            const char* a2 = last ? nA : cA + (size_t)(t + 2) * kstep; const char* b2 = last ? nB : cB + (size_t)(t + 2) * kstep;
            const char* a3 = a2 + kstep; const char* b3 = b2 + kstep;
            PG8_LDB(B0, 0, 0); PG8_LDB(B1, 0, 1); PG8_SCHED; PG8_LDA(At, 0, 0); PG8_STAGE(PG8_SA(1, 1), a1 + hstep, voffA);
            PG8_WAIT_V(8); PG8_WAIT_L(0); PG8_BAR; PG8_MMA(0, 0, At, B0); PG8_MMA(0, 1, At, B1); PG8_BAR; PG8_SCHED;
            PG8_LDA(At, 0, 1); PG8_STAGE(PG8_SB(0, 0), b2, voffA); PG8_STAGE(PG8_SB(0, 1), b2 + hstep, voffA); PG8_STAGE(PG8_SA(0, 0), a2, voffA);
            PG8_WAIT_V(8); PG8_WAIT_L(0); PG8_BAR; PG8_MMA(1, 0, At, B0); PG8_MMA(1, 1, At, B1); PG8_BAR; PG8_SCHED;
            PG8_LDB(B0, 1, 0); PG8_LDB(B1, 1, 1); PG8_SCHED; PG8_LDA(At, 1, 0); PG8_STAGE(PG8_SA(0, 1), a2 + hstep, voffA);
            PG8_WAIT_V(8); PG8_WAIT_L(0); PG8_BAR; PG8_MMA(0, 0, At, B0); PG8_MMA(0, 1, At, B1); PG8_BAR; PG8_SCHED;
            PG8_LDA(At, 1, 1); PG8_STAGE(PG8_SB(1, 0), b3, voffA); PG8_STAGE(PG8_SB(1, 1), b3 + hstep, voffA); PG8_STAGE(PG8_SA(1, 0), a3, voffA);
            PG8_WAIT_V(8); PG8_WAIT_L(0); PG8_BAR; PG8_MMA(1, 0, At, B0); PG8_MMA(1, 1, At, B1); PG8_BAR; PG8_SCHED;
        }
        if (wr == 0) PG8_BAR;
        E(acc, cur, wr, wc, fr, fq);
        if (!has_next) break;
#pragma unroll
        for (int a = 0; a < 2; ++a)
#pragma unroll
            for (int b = 0; b < 2; ++b)
#pragma unroll
                for (int m = 0; m < 4; ++m)
#pragma unroll
                    for (int n = 0; n < 2; ++n) acc[a][b][m][n] = (f32x4){0.f, 0.f, 0.f, 0.f};
        cur = nxt; cA = nA; cB = nB; ++ui;
        if (wr == 1) PG8_BAR;
    }
    PG8_WAIT_V(0);
    PG8_BAR;
#undef PG8_SA
#undef PG8_SB
#undef PG8_STAGE
#undef PG8_LDA
#undef PG8_LDB
#undef PG8_MMA
#undef PG8_WAIT_V
#undef PG8_WAIT_L
#undef PG8_BAR
#undef PG8_SCHED
}
}

__device__ __forceinline__ bool xcd_unit(int i, int MT, int NU, int& mt, int& un) {
    int bx = blockIdx.x, gx = gridDim.x;
    asm volatile("" : "+s"(NU), "+s"(MT), "+s"(bx), "+s"(gx));
    const int xcd = bx & 7, j = bx >> 3, nbx = gx >> 3;
    const int mcount = MT >> 3;
    const int q = j + i * nbx;
    if (q >= mcount * NU) return false;
    const int g = q / (8 * NU), r = q - g * 8 * NU;
    const int gsz = min(8, mcount - g * 8);
    const int ml = g * 8 + r % gsz; un = r / gsz;
    mt = ml < 16 ? 16 * xcd + ml : MLAT / 256 + xcd;
    return true;
}

__device__ __forceinline__ void phase0(const Params& p, unsigned char* smem) {
    int tid = threadIdx.x; asm volatile("" : "+v"(tid));
    constexpr int N_ADA = 192, N_WT = 4352;
    for (int item = blockIdx.x; item < N_ADA + N_WT + 1; item += gridDim.x) {
        if (item < N_ADA) {
            float* ssc = (float*)smem;
            float* red = ssc + 9 * 1024;
            const int l = item / 48, n0 = (item % 48) * 64;
            __syncthreads();
            for (int idx = tid; idx < 9 * 1024; idx += NTHR) {
                const int v = idx >> 10, kk = idx & 1023;
                const float cv = v < 8 ? p.c[v * 1024 + kk] : p.c_ctx[kk];
                ssc[idx] = cv / (1.0f + expf(-cv));
            }
            __syncthreads();
            const int kg = tid >> 6, col = tid & 63;
            float acc[9];
#pragma unroll
            for (int v = 0; v < 9; ++v) acc[v] = 0.f;
            const float* wp = p.ada_w + ((size_t)l * 1024 + kg * 128) * 3072 + n0 + col;
#pragma unroll 8
            for (int kk = 0; kk < 128; ++kk) {
                const float w = wp[(size_t)kk * 3072];
#pragma unroll
                for (int v = 0; v < 9; ++v) acc[v] += ssc[v * 1024 + kg * 128 + kk] * w;
            }
#pragma unroll
            for (int v = 0; v < 9; ++v) red[(kg * 9 + v) * 64 + col] = acc[v];
            __syncthreads();
            for (int idx = tid; idx < 9 * 64; idx += NTHR) {
                const int v = idx >> 6, cc = idx & 63;
                float s = 0.f;
#pragma unroll
                for (int g = 0; g < 8; ++g) s += red[(g * 9 + v) * 64 + cc];
                s += p.ada_b[l * 3072 + n0 + cc];
                p.mod[((size_t)l * 9 + v) * 3072 + n0 + cc] = s;
            }
        } else if (item < N_ADA + N_WT) {
            int t = item - N_ADA;
            const float* W; bf16_t* Wt; int N; int nperm = 0;
            int l = 0; bool found = false;
#pragma unroll
            for (int m = 0; m < 4; ++m) {
                const int ntl = 16 * (layer_N(m) / 64);
                if (!found) { if (t < ntl) { l = m; found = true; } else t -= ntl; }
            }
            if (found) { W = sel4(p.w_in, l); Wt = sel4(p.wt_in, l); N = layer_N(l); nperm = 1024 + ((l == 0 || l == 3) ? 256 : 1024); }
            else { l = t / 256; t = t % 256; W = sel4(p.w_out, l); Wt = sel4(p.wt_out, l); N = 1024; }
            const int k0 = (t & 15) * 64, n0 = (t >> 4) * 64;
            float* sT = (float*)smem;
            float4 v[2];
#pragma unroll
            for (int i = 0; i < 2; ++i) {
                const int kk = (tid >> 4) + 32 * i, n4 = (tid & 15) * 4;
                v[i] = *(const float4*)(W + (size_t)(k0 + kk) * N + n0 + n4);
            }
            __syncthreads();
#pragma unroll
            for (int i = 0; i < 2; ++i) {
                const int kk = (tid >> 4) + 32 * i, n4 = (tid & 15) * 4;
                sT[(n4 + 0) * 65 + kk] = v[i].x; sT[(n4 + 1) * 65 + kk] = v[i].y;
                sT[(n4 + 2) * 65 + kk] = v[i].z; sT[(n4 + 3) * 65 + kk] = v[i].w;
            }
            __syncthreads();
            {
                const int n = tid >> 3, k8 = (tid & 7) * 8;
                const float* s = sT + n * 65 + k8;
                u32x4 o; o.x = pk_bf16(s[0], s[1]); o.y = pk_bf16(s[2], s[3]); o.z = pk_bf16(s[4], s[5]); o.w = pk_bf16(s[6], s[7]);
                int f = n0 + n;
                if (f < nperm) { const int fl = f & 255, hh = fl >> 6, d = fl & 63; f = (f & ~255) + 128 * (d >> 5) + 32 * hh + (d & 31); }
                *(u32x4*)(Wt + (size_t)f * 1024 + k0 + k8) = o;
            }
        } else {
            for (int idx = tid; idx < 1024; idx += NTHR) {
                const int pos = idx >> 4, f = idx & 15;
                const float angf = (float)pos * INVF[f];
                const double a = (double)angf;
                const double kq = rint(a * 0.63661977236758134308);
                const double r = a - kq * 1.57079632679489661923;
                const double r2 = r * r;
                double sn = r * (1.0 + r2 * (-1.0 / 6 + r2 * (1.0 / 120 + r2 * (-1.0 / 5040 + r2 * (1.0 / 362880 + r2 * (-1.0 / 39916800 + r2 * (1.0 / 6227020800.0)))))));
                double cs = 1.0 + r2 * (-0.5 + r2 * (1.0 / 24 + r2 * (-1.0 / 720 + r2 * (1.0 / 40320 + r2 * (-1.0 / 3628800 + r2 * (1.0 / 479001600.0))))));
                const int qd = ((int)kq) & 3;
                double so, co;
                if (qd == 0) { so = sn; co = cs; } else if (qd == 1) { so = cs; co = -sn; } else if (qd == 2) { so = -sn; co = -cs; } else { so = -cs; co = sn; }
                p.rope[idx * 2 + 0] = (float)co; p.rope[idx * 2 + 1] = (float)so;
            }
            if (tid == 0) {
                float d1 = 0.f, d2 = 0.f;
                for (int i = 0; i < 64; ++i) { d1 += p.lq1[i] * p.lk1[i]; d2 += p.lq2[i] * p.lk2[i]; }
                p.lam[0] = expf(d1) - expf(d2) + p.lam_init;
            }
        }
    }
}

__device__ __forceinline__ const float* xin_row(const Params& p, int l, int row) {
    if (l == 0) return row < MLAT ? p.x + (size_t)row * D : p.ctx + (size_t)(row - MLAT) * D;
    return row < MLAT ? p.out + (size_t)row * D : p.xb + (size_t)(row - MLAT) * D;
}

__device__ __forceinline__ void phase_prep(const Params& p, int l, int mode) {
    asm volatile("" : "+s"(l), "+s"(mode));
    int tid = threadIdx.x; asm volatile("" : "+v"(tid));
    const int lane = tid & 63, w = tid >> 6;
    const float* g = p.norm_g + l * D;
    const int xb_ = blockIdx.x & 7, xj_ = (int)(blockIdx.x >> 3) - (mode == 1 ? 4 : 0), xn_ = (int)(gridDim.x >> 3) - (mode == 1 ? 4 : 0);
    const int lr_lo = mode == 2 ? SEQ : 0, lr_hi = mode == 1 ? SEQ : SEQ + CTXL;
    for (int lrow = lr_lo + xj_ * 8 + w; lrow < lr_hi; lrow += xn_ * 8) {
        const int row = lrow < SEQ ? xb_ * SEQ + lrow : MLAT + xb_ * CTXL + (lrow - SEQ);
        const float* xr = xin_row(p, l, row);
        const int bv = row < MLAT ? (row >> 12) : 8;
        const float* md = p.mod + ((size_t)l * 9 + bv) * 3072;
        float4 v[4]; float ss = 0.f;
#pragma unroll
        for (int j = 0; j < 4; ++j) {
            v[j] = *(const float4*)(xr + j * 256 + lane * 4);
            ss += v[j].x * v[j].x + v[j].y * v[j].y + v[j].z * v[j].z + v[j].w * v[j].w;
        }
#pragma unroll
        for (int o = 32; o >= 1; o >>= 1) ss += __shfl_xor(ss, o);
        const float rstd = rsqrtf(ss * (1.0f / 1024.0f) + EPS);
#pragma unroll
        for (int j = 0; j < 4; ++j) {
            const int col = j * 256 + lane * 4;
            const float4 gg = *(const float4*)(g + col);
            const float4 sh = *(const float4*)(md + col);
            const float4 sc = *(const float4*)(md + 1024 + col);
            const float a0 = v[j].x * rstd * gg.x * (1.0f + sc.x) + sh.x;
            const float a1 = v[j].y * rstd * gg.y * (1.0f + sc.y) + sh.y;
            const float a2 = v[j].z * rstd * gg.z * (1.0f + sc.z) + sh.z;
            const float a3 = v[j].w * rstd * gg.w * (1.0f + sc.w) + sh.w;
            u32x2 o; o.x = pk_bf16(a0, a1); o.y = pk_bf16(a2, a3);
            *(u32x2*)(p.h + (size_t)row * D + col) = o;
        }
    }
}

struct InSched {
    const char* h; const char* wt; int nK, NU; bool vrow;
    __device__ __forceinline__ bool next(int i, pg8::Unit& u) const {
        int mt, un;
        if (!xcd_unit(i, MTOT / 256, NU, mt, un)) return false;
        u.pm = mt; u.pn = un;
        const char* hp = h + (size_t)mt * 256 * D * 2;
        const char* wp = wt + (size_t)un * 256 * D * 2;
        const int kind = un < 4 ? 0 : (un < 4 + nK ? 1 : (un < 4 + 2 * nK ? 2 : 3));
        u.kind = (kind == 2 && vrow) ? 4 : kind;
        if (u.kind == 2) { u.a = wp; u.b = hp; } else { u.a = hp; u.b = wp; }
        return true;
    }
};

struct EpiIn {
    const LAS float* ropeL; const LAS float* gL; bf16_t *q, *k, *vt, *sz; int nK; bool do_rope; LAS unsigned char* stg0;
    __device__ __forceinline__ void operator()(const f32x4 (&acc)[2][2][4][2], const pg8::Unit& u, int wr, int wc, int fr, int fq) const {
        const int row0 = u.pm * 256;
        const bool isctx = row0 >= MLAT;
        int b, t0, pos0;
        if (!isctx) { b = row0 >> 12; t0 = row0 & 4095; pos0 = CTXL + t0; } else { b = (row0 - MLAT) >> 8; t0 = 0; pos0 = 0; }
        const int lane = fr + 16 * fq, wid = wr * 4 + wc;
        LAS unsigned char* stg = stg0 + wid * 2304;
        LAS unsigned char* wp = stg + fr * 144 + fq * 8;
        const int rr = lane >> 2, ch = lane & 3;
        const LAS unsigned char* rp = stg + rr * 144 + ch * 32;
        bf16_t* dbase; size_t rpitch; int coff;
        const int kind = u.kind;
        if (kind == 3) { dbase = sz + (size_t)row0 * D + (u.pn - 4 - 2 * nK) * 256 + wc * 32; rpitch = D; coff = (ch >> 1) * 128 + (ch & 1) * 16; }
        else if (kind == 4) { const int VH = nK * 4; const int vh = (u.pn - 4 - nK) * 4 + (wc >> 1) + 2 * (ch >> 1);
            dbase = vt + (((size_t)b * VH + vh) * TT + pos0) * 64 + (wc & 1) * 32; rpitch = 64; coff = (ch & 1) * 16; }
        else if (kind == 2) { const int VF = nK * 256;
            dbase = vt + ((size_t)b * VF + (u.pn - 4 - nK) * 256) * TT + pos0 + wc * 32; rpitch = TT; coff = (ch >> 1) * 128 + (ch & 1) * 16; }
        else { const bool isq = kind == 0; const int head = isq ? u.pn * 4 + wc : (u.pn - 4) * 4 + wc;
            dbase = (isq ? q + ((size_t)b * 16 + head) * TT * 64 : k + ((size_t)b * (nK * 4) + head) * TT * 64) + (size_t)pos0 * 64; rpitch = 64; coff = ch * 16; }
        const LAS float* gp = gL + (kind == 0 ? 0 : 64);
        const float osc = kind == 0 ? QSCALE : 1.0f;
        const bool rp_on = do_rope && !isctx;
        f32x4 g4[2][2], rc[2][2], ccur[2], cnxt[2];
        if (kind <= 1) {
#pragma unroll
            for (int bj = 0; bj < 2; ++bj)
#pragma unroll
                for (int n = 0; n < 2; ++n) g4[bj][n] = *(const LAS f32x4*)(gp + 32 * bj + 16 * n + 4 * fq);
#pragma unroll
            for (int ai = 0; ai < 2; ++ai) {
                const int pos = ((t0 >> 6) + 2 * ai + wr) & 63;
                rc[ai][0] = *(const LAS f32x4*)(ropeL + (pos * 16 + 4 * fq) * 2); rc[ai][1] = *(const LAS f32x4*)(ropeL + (pos * 16 + 4 * fq) * 2 + 4);
            }
            ccur[0] = *(const LAS f32x4*)(ropeL + (fr * 16 + 4 * fq) * 2); ccur[1] = *(const LAS f32x4*)(ropeL + (fr * 16 + 4 * fq) * 2 + 4);
        }
#pragma unroll
        for (int m = 0; m < 4; ++m) {
            if (kind <= 1 && m < 3) { const int pos = (m + 1) * 16 + fr; cnxt[0] = *(const LAS f32x4*)(ropeL + (pos * 16 + 4 * fq) * 2); cnxt[1] = *(const LAS f32x4*)(ropeL + (pos * 16 + 4 * fq) * 2 + 4); }
#pragma unroll
            for (int ai = 0; ai < 2; ++ai) {
                const int tl = ai * 128 + wr * 64 + m * 16;
                u32x2 o[2][2];
                if (kind == 3) {
#pragma unroll
                    for (int bj = 0; bj < 2; ++bj)
#pragma unroll
                        for (int n = 0; n < 2; ++n) { const f32x4 v = acc[ai][bj][m][n]; o[bj][n].x = pk_bf16(silu_f(v[0]), silu_f(v[1])); o[bj][n].y = pk_bf16(silu_f(v[2]), silu_f(v[3])); }
                } else if (kind >= 2) {
#pragma unroll
                    for (int bj = 0; bj < 2; ++bj)
#pragma unroll
                        for (int n = 0; n < 2; ++n) { const f32x4 v = acc[ai][bj][m][n]; o[bj][n].x = pk_bf16(v[0], v[1]); o[bj][n].y = pk_bf16(v[2], v[3]); }
                } else {
                    float ss = 0.f;
#pragma unroll
                    for (int bj = 0; bj < 2; ++bj)
#pragma unroll
                        for (int n = 0; n < 2; ++n) { const f32x4 v = acc[ai][bj][m][n]; ss += v[0] * v[0] + v[1] * v[1] + v[2] * v[2] + v[3] * v[3]; }
                    ss += __shfl_xor(ss, 16); ss += __shfl_xor(ss, 32);
                    const float rstd = rsqrtf(ss * (1.0f / 64.0f) + EPS);
#pragma unroll
                    for (int bj = 0; bj < 2; ++bj) {
                        f32x4 x1 = acc[ai][bj][m][0] * rstd * g4[bj][0];
                        f32x4 x2 = acc[ai][bj][m][1] * rstd * g4[bj][1];
                        {
                            const f32x4 cs0 = bj == 0 ? rc[ai][0] : ccur[0], cs1 = bj == 0 ? rc[ai][1] : ccur[1];
                            f32x4 cc = (f32x4){cs0[0], cs0[2], cs1[0], cs1[2]}, sn = (f32x4){cs0[1], cs0[3], cs1[1], cs1[3]};
                            if (!rp_on) { cc = (f32x4){1.f, 1.f, 1.f, 1.f}; sn = (f32x4){0.f, 0.f, 0.f, 0.f}; }
                            const f32x4 y1 = x1 * cc - x2 * sn, y2 = x2 * cc + x1 * sn;
                            x1 = y1; x2 = y2;
                        }
                        x1 = x1 * osc; x2 = x2 * osc;
                        o[bj][0].x = pk_bf16(x1[0], x1[1]); o[bj][0].y = pk_bf16(x1[2], x1[3]); o[bj][1].x = pk_bf16(x2[0], x2[1]); o[bj][1].y = pk_bf16(x2[2], x2[3]);
                    }
                }
#pragma unroll
                for (int bj = 0; bj < 2; ++bj)
#pragma unroll
                    for (int n = 0; n < 2; ++n) *(LAS u32x2*)(wp + (32 * bj + 16 * n) * 2) = o[bj][n];
                const u32x4 r0 = *(const LAS u32x4*)(rp), r1 = *(const LAS u32x4*)(rp + 16);
                bf16_t* dp = dbase + (size_t)(tl + rr) * rpitch + coff;
                *(u32x4*)(dp) = r0; *(u32x4*)(dp + 8) = r1;
            }
            ccur[0] = cnxt[0]; ccur[1] = cnxt[1];
        }
    }
};

__device__ __forceinline__ void phase_inproj(const Params& p, int l, unsigned char* smem) {
    const int kind = l % 3;
    InSched S; S.h = (const char*)p.h; S.wt = (const char*)sel4(p.wt_in, l); S.nK = kind == 0 ? 1 : 4; S.NU = 8 + 2 * S.nK; S.vrow = true;
    LAS float* ropeL = (LAS float*)((LAS unsigned char*)smem + 131072 + 18432);
    LAS float* gL = ropeL + 2048;
    {
        int tid = threadIdx.x; asm volatile("" : "+v"(tid));
        *(LAS f32x4*)(ropeL + tid * 4) = *(const f32x4*)(p.rope + tid * 4);
        if (tid < 64) gL[tid] = sel4(p.q_g, l)[tid]; else if (tid < 128) gL[tid] = sel4(p.k_g, l)[tid - 64];
        __syncthreads();
    }
    EpiIn E; E.ropeL = ropeL; E.gL = gL; E.q = p.q; E.k = p.k; E.vt = p.vt; E.sz = p.sz; E.nK = S.nK; E.do_rope = kind != 1; E.stg0 = (LAS unsigned char*)smem + 131072;
    pg8::gemm_phase(( LAS unsigned char*)smem, 1024, S, E);
}

struct OutSched {
    const char* og; const char* wt; int MT; bool ctxonly;
    __device__ __forceinline__ bool next(int i, pg8::Unit& u) const {
        int mt, un;
        if (ctxonly) { if (i > 0 || (blockIdx.x >> 3) >= 4) return false; mt = MLAT / 256 + (blockIdx.x & 7); un = blockIdx.x >> 3; }
        else if (!xcd_unit(i, MT, 4, mt, un)) return false;
        u.pm = mt; u.pn = un; u.kind = 0;
        u.a = og + (size_t)mt * 256 * D * 2; u.b = wt + (size_t)un * 256 * D * 2;
        return true;
    }
};
struct EpiOut {
    const float *x, *ctx, *mod; float *out, *xb; int l;
    __device__ __forceinline__ void operator()(const f32x4 (&acc)[2][2][4][2], const pg8::Unit& u, int wr, int wc, int fr, int fq) const {
        const int row0 = u.pm * 256;
        const bool isctx = row0 >= MLAT;
        const int bv = isctx ? 8 : (row0 >> 12);
        const int n0 = u.pn * 256 + wc * 32 + 4 * fq;
        const float* gtp = mod + ((size_t)l * 9 + bv) * 3072 + 2048 + n0;
        f32x4 g4[2][2];
#pragma unroll
        for (int bj = 0; bj < 2; ++bj)
#pragma unroll
            for (int n = 0; n < 2; ++n) g4[bj][n] = *(const f32x4*)(gtp + bj * 128 + n * 16);
        const float* src = l == 0 ? (isctx ? ctx + (size_t)(row0 - MLAT) * D : x + (size_t)row0 * D) : (isctx ? xb + (size_t)(row0 - MLAT) * D : out + (size_t)row0 * D);
        float* dstp = isctx ? xb + (size_t)(row0 - MLAT) * D : out + (size_t)row0 * D;
#pragma unroll
        for (int ai = 0; ai < 2; ++ai)
#pragma unroll
            for (int m = 0; m < 4; ++m) {
                const size_t ro = (size_t)(ai * 128 + wr * 64 + m * 16 + fr) * D + n0;
                f32x4 xv[2][2];
#pragma unroll
                for (int bj = 0; bj < 2; ++bj)
#pragma unroll
                    for (int n = 0; n < 2; ++n) xv[bj][n] = *(const f32x4*)(src + ro + bj * 128 + n * 16);
#pragma unroll
                for (int bj = 0; bj < 2; ++bj)
#pragma unroll
                    for (int n = 0; n < 2; ++n) *(f32x4*)(dstp + ro + bj * 128 + n * 16) = xv[bj][n] + g4[bj][n] * acc[ai][bj][m][n];
            }
    }
};

__device__ __forceinline__ void phase_outproj(const Params& p, int l, bool ctxonly, unsigned char* smem) {
    OutSched S; S.og = (const char*)p.og; S.wt = (const char*)sel4(p.wt_out, l); S.MT = MLAT / 256; S.ctxonly = ctxonly;
    EpiOut E; E.x = p.x; E.ctx = p.ctx; E.mod = p.mod; E.out = p.out; E.xb = p.xb; E.l = l;
    pg8::gemm_phase((LAS unsigned char*)smem, 1024, S, E);
}

namespace attn_a {
typedef unsigned short bf16;
using s16x4=__attribute__((ext_vector_type(4)))short;
constexpr int PQ=64;
constexpr int NW=8,QBLK=32,QB=QBLK*NW,KVBLK=64;
__device__ __forceinline__ int crow(int r,int hi){return (r&3)+8*(r>>2)+4*hi;}
#define SBAR() __builtin_amdgcn_sched_barrier(0)
__device__ __forceinline__ void cmask(f32x16&p0,f32x16&p1,int jb,int qrel,int hi){
  const float NEG=-INFINITY; int kb=64*jb+4*hi;
  #pragma unroll
  for(int r=0;r<16;++r){int kv=kb+(r&3)+8*(r>>2); if(kv>qrel)p0[r]=NEG; if(kv+32>qrel)p1[r]=NEG;}
}

constexpr int NSLOT=3, SLOTB=8192;
constexpr int LDS_K=0, LDS_V=NSLOT*SLOTB, LDS_WS=2*NSLOT*SLOTB, LDS_OST=LDS_WS+NW*64*4, LDS_BYTES=LDS_OST+NW*4096;
constexpr float C2=0.125f*1.4426950408889634f;
__device__ __forceinline__ void glds16(const void*gsrc,unsigned lds_dst){unsigned keep;
  asm volatile("s_mov_b32 %0, m0\n\ts_mov_b32 m0, %2\n\ts_nop 0\n\tglobal_load_lds_dwordx4 %1, off\n\ts_mov_b32 m0, %0":"=&s"(keep):"v"(gsrc),"s"(lds_dst):"memory");}
__device__ __forceinline__ float max3f(float a,float b,float c){float r;asm("v_max3_f32 %0, %1, %2, %3":"=v"(r):"v"(a),"v"(b),"v"(c));return r;}
__device__ __forceinline__ float max2f(float a,float b){float r;asm("v_max_f32_e32 %0, %1, %2":"=v"(r):"v"(a),"v"(b));return r;}
__device__ __forceinline__ float fadd_s(float a,float b){float r;asm("v_add_f32_e32 %0, %1, %2":"=v"(r):"v"(a),"v"(b));return r;}
__device__ __forceinline__ float fsub_s(float a,float b){float r;asm("v_sub_f32_e32 %0, %1, %2":"=v"(r):"v"(a),"v"(b));return r;}
typedef float f32x2_t __attribute__((ext_vector_type(2))); typedef __bf16 bf16x2_t __attribute__((ext_vector_type(2)));
__device__ __forceinline__ unsigned cvtpk_s(float lo,float hi){f32x2_t v={lo,hi};bf16x2_t b=__builtin_convertvector(v,bf16x2_t);return __builtin_bit_cast(unsigned,b);}
#define WAIT_BAR(N) asm volatile("s_waitcnt vmcnt(" #N ") lgkmcnt(0)\n\ts_barrier":::"memory")

__device__ __forceinline__ void qkt(f32x16&p0,f32x16&p1,const char*Kslot,const bf16x8*qr,const f32x16&negm,int r32,int hi){
  const char*kb=Kslot+hi*1024+r32*16;
  #pragma unroll
  for(int d0=0;d0<4;++d0){
    const bf16x8 b0=*reinterpret_cast<const bf16x8*>(kb+d0*2048);
    const bf16x8 b1=*reinterpret_cast<const bf16x8*>(kb+d0*2048+512);
    if(d0==0){p0=__builtin_amdgcn_mfma_f32_32x32x16_bf16(b0,qr[0],negm,0,0,0);p1=__builtin_amdgcn_mfma_f32_32x32x16_bf16(b1,qr[0],negm,0,0,0);}
    else{p0=__builtin_amdgcn_mfma_f32_32x32x16_bf16(b0,qr[d0],p0,0,0,0);p1=__builtin_amdgcn_mfma_f32_32x32x16_bf16(b1,qr[d0],p1,0,0,0);}}
}
typedef __attribute__((address_space(3))) const char* lds_cptr;
typedef short v4i16_t __attribute__((ext_vector_type(4)));
__device__ __forceinline__ void kload8(bf16x8*kf,lds_cptr kp){
  kf[0]=*(const __attribute__((address_space(3))) bf16x8*)(kp);      kf[1]=*(const __attribute__((address_space(3))) bf16x8*)(kp+512);
  kf[2]=*(const __attribute__((address_space(3))) bf16x8*)(kp+2048); kf[3]=*(const __attribute__((address_space(3))) bf16x8*)(kp+2560);
  kf[4]=*(const __attribute__((address_space(3))) bf16x8*)(kp+4096); kf[5]=*(const __attribute__((address_space(3))) bf16x8*)(kp+4608);
  kf[6]=*(const __attribute__((address_space(3))) bf16x8*)(kp+6144); kf[7]=*(const __attribute__((address_space(3))) bf16x8*)(kp+6656);
}
__device__ __forceinline__ void kload2(bf16x8*kf,lds_cptr kp,int j){ kf[2*j]=*(const __attribute__((address_space(3))) bf16x8*)(kp+j*2048); kf[2*j+1]=*(const __attribute__((address_space(3))) bf16x8*)(kp+j*2048+512); }
__device__ __forceinline__ s16x4 vtr(lds_cptr p){ return __builtin_bit_cast(s16x4,__builtin_amdgcn_ds_read_tr16_b64_v4i16((__attribute__((address_space(3))) v4i16_t*)p)); }
__device__ __forceinline__ float rowmax(const f32x16&p0,const f32x16&p1){
  float a=max3f(p0[0],p0[1],p1[0]),b=max3f(p0[2],p0[3],p1[1]);a=max3f(a,p1[2],p1[3]);
  #pragma unroll
  for(int r=4;r<16;r+=4){a=max3f(a,p0[r],p0[r+1]);b=max3f(b,p0[r+2],p0[r+3]);a=max3f(a,p1[r],p1[r+1]);b=max3f(b,p1[r+2],p1[r+3]);}
  const float m=max2f(a,b);
  auto rr=__builtin_amdgcn_permlane32_swap(__float_as_uint(m),__float_as_uint(m),false,false);
  return max2f(__uint_as_float(rr[0]),__uint_as_float(rr[1]));
}
__device__ __forceinline__ void pv(f32x16*o,int vb,bf16x8 pa0,bf16x8 pa1,bf16x8 pa2,bf16x8 pa3){
  #pragma unroll
  for(int d0=0;d0<2;++d0){s16x4 lo[4],hi[4];
    #pragma unroll
    for(int ks=0;ks<4;++ks){
      asm volatile("ds_read_b64_tr_b16 %0,%1 offset:%c2":"=&v"(lo[ks]):"v"(vb),"i"(d0*4096+ks*1024):"memory");
      asm volatile("ds_read_b64_tr_b16 %0,%1 offset:%c2":"=&v"(hi[ks]):"v"(vb),"i"(d0*4096+ks*1024+512):"memory");}
    asm volatile("s_waitcnt lgkmcnt(0)":::"memory");SBAR();
    #define PK(k) (bf16x8){lo[k][0],lo[k][1],lo[k][2],lo[k][3],hi[k][0],hi[k][1],hi[k][2],hi[k][3]}
    o[d0]=__builtin_amdgcn_mfma_f32_32x32x16_bf16(pa0,PK(0),o[d0],0,0,0);
    o[d0]=__builtin_amdgcn_mfma_f32_32x32x16_bf16(pa1,PK(1),o[d0],0,0,0);
    o[d0]=__builtin_amdgcn_mfma_f32_32x32x16_bf16(pa2,PK(2),o[d0],0,0,0);
    o[d0]=__builtin_amdgcn_mfma_f32_32x32x16_bf16(pa3,PK(3),o[d0],0,0,0);
    #undef PK
  }
}

template<int THRL,bool NBRM=false,bool DV2=false> __device__ __forceinline__ void attn_unit(const bf16*Qu,const bf16*__restrict__ Kh,const bf16*__restrict__ Vh,const int NT,const bf16*SZu,bf16*OGu,char*shm,
                                                                      const int rowoff=0,const int qrow0=0,const LAS float*rpbL=nullptr,const bf16*__restrict__ V2h=nullptr,float*Oraw=nullptr){
  constexpr int LDS_V2=LDS_BYTES, ND=DV2?4:2;
  #define WB(a,b) do{ if constexpr(DV2){WAIT_BAR(b);} else {WAIT_BAR(a);} }while(0)
  int tid=threadIdx.x; asm volatile("":"+v"(tid)); const int lane=tid&63,r32=lane&31,hi=lane>>5; const int wid=__builtin_amdgcn_readfirstlane(tid>>6);
  const bf16*Qw=Qu+(long)wid*QBLK*PQ;
  const unsigned lds0=(unsigned)(uintptr_t)shm;
  float*wsf=(float*)(shm+LDS_WS)+wid*64;
  const bf16*ksrc=Kh+(long)lane*PQ+wid*8;
  const bf16*vsrc=Vh+(long)(16*(wid&3)+(lane>>2))*PQ+(wid>>2)*32+(lane&3)*8;
  const unsigned kdst=lds0+LDS_K+wid*1024, vdst=lds0+LDS_V+wid*1024;
  #define TMAP(t) ((NBRM&&(t)>=4)?((t)+rowoff):(t))
  #define DMA_K(t,slot) glds16(ksrc+(long)TMAP(t)*KVBLK*PQ,(unsigned)__builtin_amdgcn_readfirstlane(kdst+(slot)))
  #define DMA_V(t,slot) glds16(vsrc+(long)TMAP(t)*KVBLK*PQ,(unsigned)__builtin_amdgcn_readfirstlane(vdst+(slot)))
  const bf16*v2src=DV2?V2h+(vsrc-Vh):vsrc; const unsigned v2dst=lds0+LDS_V2+wid*1024;
  #define DMA_V2(t,slot) do{ if constexpr(DV2) glds16(v2src+(long)TMAP(t)*KVBLK*PQ,(unsigned)__builtin_amdgcn_readfirstlane(v2dst+(slot))); }while(0)
  const int vb0=(int)(lds0+LDS_V)+((lane>>4)&1)*32+(lane&3)*8+(4*hi+((lane&15)>>2))*64;
  const char*Kbase=shm+LDS_K; bf16x8 kf[8];
  const lds_cptr shm3=(lds_cptr)shm; const lds_cptr kp0=shm3+LDS_K+hi*1024+r32*16; const lds_cptr vp0=shm3+LDS_V+((lane>>4)&1)*32+(lane&3)*8+(4*hi+((lane&15)>>2))*64;
  DMA_K(0,0);DMA_V(0,0);DMA_V2(0,0);DMA_K(1,SLOTB);
  bf16x8 qr[4];
  #pragma unroll
  for(int d0=0;d0<4;++d0)qr[d0]=*reinterpret_cast<const bf16x8*>(&Qw[(long)r32*PQ+d0*16+hi*8]);
  float mhat=0.f,l_reg=0.f;f32x16 o[ND];
  #pragma unroll
  for(int d_=0;d_<ND;++d_)o[d_]=f32x16{};
  f32x16 negm=f32x16{}; if constexpr(!DV2) asm volatile("":"+v"(negm));
  const f32x16 zero16=f32x16{};
  #define NEGM (DV2?zero16:negm)
  const int nq_r=qrow0+(wid>>1), nq_c=(wid&1)*32+r32, n_rsw=min(max(nq_r-4,0),56), n_cs=min(max(nq_c-8,0),48);
  #define CMASK(P0,P1,t) do{ if constexpr(NBRM){ const int t_=(t); if(t_>=4){ const int kr_=rowoff+t_-4; \
      if((unsigned)(kr_-n_rsw)>=8u){ _Pragma("unroll") for(int r=0;r<16;++r){P0[r]=-INFINITY;P1[r]=-INFINITY;} } \
      else{ const LAS float*bp_=rpbL+(kr_-nq_r+7)*31+15-nq_c; \
        _Pragma("unroll") for(int r=0;r<16;++r){ const int kc_=crow(r,hi); \
          const bool v0_=(unsigned)(kc_-n_cs)<16u, v1_=(unsigned)(kc_+32-n_cs)<16u; \
          const float b0_=v0_?bp_[kc_]:0.f, b1_=v1_?bp_[kc_+32]:0.f; \
          P0[r]=v0_?P0[r]+b0_:-INFINITY; P1[r]=v1_?P1[r]+b1_:-INFINITY; } } } } }while(0)
  bool resc=false;
  #define START(P0,P1) do{ const float rm=rowmax(P0,P1); resc=false; \
    { const float dl=rm; mhat=fadd_s(mhat,dl); \
      _Pragma("unroll") for(int r=0;r<16;++r){P0[r]=fsub_s(P0[r],dl);P1[r]=fsub_s(P1[r],dl);} \
      if constexpr(!DV2){ _Pragma("unroll") for(int r=0;r<16;++r)negm[r]=-mhat; asm volatile("":"+v"(negm)); } } \
    _Pragma("unroll") for(int r=0;r<16;++r)P0[r]=__builtin_amdgcn_exp2f(P0[r]); }while(0)
  #define RESC() do{ if(resc){ asm volatile("s_waitcnt lgkmcnt(0)":::"memory"); \
      _Pragma("unroll") for(int d_=0;d_<ND;++d_) _Pragma("unroll") for(int r=0;r<16;++r)o[d_][r]*=wsf[crow(r,hi)]; } }while(0)
  f32x16 pA0,pA1,pB0,pB1;
  int sl_prev=0,sl_cur=0,sl_next=SLOTB;
  #define ROT() do{sl_prev=sl_cur;sl_cur=sl_next;sl_next=(sl_next==(NSLOT-1)*SLOTB)?0:sl_next+SLOTB;}while(0)
  DMA_K(2,2*SLOTB);
  WB(3,4);
  qkt(pA0,pA1,Kbase,qr,NEGM,r32,hi);asm volatile("s_nop 15\n\ts_nop 7":"+v"(pA0),"+v"(pA1));CMASK(pA0,pA1,0);
  START(pA0,pA1);
  _Pragma("unroll") for(int r=0;r<16;++r)pA1[r]=__builtin_amdgcn_exp2f(pA1[r]);
  WAIT_BAR(0);
  DMA_K(3,0);DMA_V(1,SLOTB);DMA_V2(1,SLOTB);
  ROT();
  kload8(kf,kp0+sl_cur);
  WB(2,3);
  s16x4 vlo[8],vhi[8]; u32x4 pw0,pw1,pw2,pw3;
  #define PKW(P,B) cvtpk_s(P[B],P[B+1])
  #define PAF(k) __builtin_bit_cast(bf16x8,pw##k)
  #define VFR(i) (bf16x8){vlo[i][0],vlo[i][1],vlo[i][2],vlo[i][3],vhi[i][0],vhi[i][1],vhi[i][2],vhi[i][3]}
  #define PIN(x) asm volatile("":"+v"(x))
  #define MX3(a,b,c) __builtin_fmaxf(__builtin_fmaxf((a),(b)),(c))
  #define GAPA(MF,A0,A1,A2,A3,W0,W1,PW) do{ MF; sacc+=A0; sacc+=A1; sacc+=A2; sacc+=A3; PIN(sacc); W0; W1; PIN(PW); SBAR(); }while(0)
  #define EX(v) (DV2?__builtin_amdgcn_exp2f((v)-mhat):__builtin_amdgcn_exp2f(v))
  #define GAPB(MF,X,B) do{ MF; X[B]=EX(X[B]); X[B+1]=EX(X[B+1]); X[B+2]=EX(X[B+2]); X[B+3]=EX(X[B+3]); PIN(X); SBAR(); }while(0)
  #define GAPH(MF,X,B) do{ MF; X[B]=EX(X[B]); X[B+1]=EX(X[B+1]); PIN(X); SBAR(); }while(0)
  #define GAPX(MF,XA,BA,XH,BH) do{ if constexpr(DV2){ GAPH(MF,XH,BH); } else { GAPB(MF,XA,BA); } }while(0)
  #define VRD(i) do{ vlo[i]=vtr(vp_+(((i)>>2)*4096+((i)&3)*1024)); vhi[i]=vtr(vp_+(((i)>>2)*4096+((i)&3)*1024+512)); }while(0)
  #define KRD(G,j) do{ if(G){ kload2(kf,kp0+sl_next,j); SBAR(); } }while(0)
  #define KRD1(G,j) do{ if constexpr(!DV2){ KRD(G,j); } }while(0)
  #define V2R(i) do{ if constexpr(DV2){ vlo[i]=vtr(vq_+(((i)>>2)*4096+((i)&3)*1024)); vhi[i]=vtr(vq_+(((i)>>2)*4096+((i)&3)*1024+512)); SBAR(); } }while(0)
  #define STEP(C0,C1,P0,P1,t,GK,GV,GL) do{ SBAR(); \
    const lds_cptr vp_=vp0+sl_prev; const lds_cptr vq_=vp0+(LDS_V2-LDS_V)+sl_prev; (void)vq_; \
    VRD(0); SBAR(); float sacc=(P0[0]+P0[1]); \
    GAPA(C0=__builtin_amdgcn_mfma_f32_32x32x16_bf16(kf[0],qr[0],NEGM,0,0,0), P0[2],P0[3],P0[4],P0[5],     pw0[0]=PKW(P0,0), pw0[1]=PKW(P0,2), pw0); \
    VRD(4); SBAR(); GAPA(C1=__builtin_amdgcn_mfma_f32_32x32x16_bf16(kf[1],qr[0],NEGM,0,0,0), P0[6],P0[7],P0[8],P0[9],     pw0[2]=PKW(P0,4), pw0[3]=PKW(P0,6), pw0); \
    VRD(1); SBAR(); GAPA(C0=__builtin_amdgcn_mfma_f32_32x32x16_bf16(kf[2],qr[1],C0,0,0,0),   P0[10],P0[11],P0[12],P0[13], pw1[0]=PKW(P0,8), pw1[1]=PKW(P0,10), pw1); \
    VRD(5); SBAR(); GAPA(C1=__builtin_amdgcn_mfma_f32_32x32x16_bf16(kf[3],qr[1],C1,0,0,0),   P0[14],P0[15],P1[0],P1[1],   pw1[2]=PKW(P0,12),pw1[3]=PKW(P0,14), pw1); \
    VRD(2); SBAR(); GAPA(C0=__builtin_amdgcn_mfma_f32_32x32x16_bf16(kf[4],qr[2],C0,0,0,0),   P1[2],P1[3],P1[4],P1[5],     pw2[0]=PKW(P1,0), pw2[1]=PKW(P1,2), pw2); \
    VRD(6); SBAR(); GAPA(C1=__builtin_amdgcn_mfma_f32_32x32x16_bf16(kf[5],qr[2],C1,0,0,0),   P1[6],P1[7],P1[8],P1[9],     pw2[2]=PKW(P1,4), pw2[3]=PKW(P1,6), pw2); \
    VRD(3); SBAR(); GAPA(C0=__builtin_amdgcn_mfma_f32_32x32x16_bf16(kf[6],qr[3],C0,0,0,0),   P1[10],P1[11],P1[12],P1[13], pw3[0]=PKW(P1,8), pw3[1]=PKW(P1,10), pw3); \
    VRD(7); SBAR(); GAPA(C1=__builtin_amdgcn_mfma_f32_32x32x16_bf16(kf[7],qr[3],C1,0,0,0),   P1[14],P1[15],0.f,0.f,       pw3[2]=PKW(P1,12),pw3[3]=PKW(P1,14), pw3); \
    l_reg+=sacc; \
    if(GK){DMA_K((t)+3,sl_cur);} if(GV){DMA_V((t)+1,sl_next);DMA_V2((t)+1,sl_next);} \
    CMASK(C0,C1,t); \
    { float a=MX3(C0[0],C0[1],C1[0]),b=MX3(C0[2],C0[3],C1[1]); a=MX3(a,C1[2],C1[3]); \
      _Pragma("unroll") for(int r=4;r<16;r+=4){a=MX3(a,C0[r],C0[r+1]);b=MX3(b,C0[r+2],C0[r+3]);a=MX3(a,C1[r],C1[r+1]);b=MX3(b,C1[r+2],C1[r+3]);} \
      float rm=__builtin_fmaxf(a,b); { auto rr=__builtin_amdgcn_permlane32_swap(__float_as_uint(rm),__float_as_uint(rm),false,false); rm=__builtin_fmaxf(__uint_as_float(rr[0]),__uint_as_float(rr[1])); } \
      if constexpr(DV2) rm-=mhat; \
      resc=false; \
      if(__builtin_expect(__any(rm>(float)THRL),0)){ const float dl=__builtin_fmaxf(rm,0.f); mhat+=dl; \
        if constexpr(!DV2){ _Pragma("unroll") for(int r=0;r<16;++r){C0[r]-=dl;C1[r]-=dl;} } \
        if constexpr(!DV2){ _Pragma("unroll") for(int r=0;r<16;++r)negm[r]=-mhat; asm volatile("":"+v"(negm)); } \
        const float f=__builtin_amdgcn_exp2f(-dl); l_reg*=f; if(hi==0)wsf[r32]=f; resc=true; } } \
    SBAR(); \
    GAPX(o[0]=__builtin_amdgcn_mfma_f32_32x32x16_bf16(PAF(0),VFR(0),o[0],0,0,0), C0,0,  C0,0); V2R(0); \
    GAPX(o[1]=__builtin_amdgcn_mfma_f32_32x32x16_bf16(PAF(0),VFR(4),o[1],0,0,0), C0,4,  C0,2); V2R(4); \
    KRD1(GL,0); GAPX(o[0]=__builtin_amdgcn_mfma_f32_32x32x16_bf16(PAF(1),VFR(1),o[0],0,0,0), C0,8,  C0,4); V2R(1); \
    KRD1(GL,1); GAPX(o[1]=__builtin_amdgcn_mfma_f32_32x32x16_bf16(PAF(1),VFR(5),o[1],0,0,0), C0,12, C0,6); V2R(5); \
    KRD1(GL,2); GAPX(o[0]=__builtin_amdgcn_mfma_f32_32x32x16_bf16(PAF(2),VFR(2),o[0],0,0,0), C1,0,  C0,8); V2R(2); \
    KRD1(GL,3); GAPX(o[1]=__builtin_amdgcn_mfma_f32_32x32x16_bf16(PAF(2),VFR(6),o[1],0,0,0), C1,4,  C0,10); V2R(6); \
    GAPX(o[0]=__builtin_amdgcn_mfma_f32_32x32x16_bf16(PAF(3),VFR(3),o[0],0,0,0), C1,8,  C0,12); V2R(3); \
    GAPX(o[1]=__builtin_amdgcn_mfma_f32_32x32x16_bf16(PAF(3),VFR(7),o[1],0,0,0), C1,12, C0,14); V2R(7); \
    if constexpr(DV2){ \
      GAPH(o[ND-2]=__builtin_amdgcn_mfma_f32_32x32x16_bf16(PAF(0),VFR(0),o[ND-2],0,0,0), C1,0); \
      GAPH(o[ND-1]=__builtin_amdgcn_mfma_f32_32x32x16_bf16(PAF(0),VFR(4),o[ND-1],0,0,0), C1,2); \
      KRD(GL,0); GAPH(o[ND-2]=__builtin_amdgcn_mfma_f32_32x32x16_bf16(PAF(1),VFR(1),o[ND-2],0,0,0), C1,4); \
      KRD(GL,1); GAPH(o[ND-1]=__builtin_amdgcn_mfma_f32_32x32x16_bf16(PAF(1),VFR(5),o[ND-1],0,0,0), C1,6); \
      KRD(GL,2); GAPH(o[ND-2]=__builtin_amdgcn_mfma_f32_32x32x16_bf16(PAF(2),VFR(2),o[ND-2],0,0,0), C1,8); \
      KRD(GL,3); GAPH(o[ND-1]=__builtin_amdgcn_mfma_f32_32x32x16_bf16(PAF(2),VFR(6),o[ND-1],0,0,0), C1,10); \
      GAPH(o[ND-2]=__builtin_amdgcn_mfma_f32_32x32x16_bf16(PAF(3),VFR(3),o[ND-2],0,0,0), C1,12); \
      GAPH(o[ND-1]=__builtin_amdgcn_mfma_f32_32x32x16_bf16(PAF(3),VFR(7),o[ND-1],0,0,0), C1,14); } \
    }while(0)
  int t=1;
  for(;t+5<NT;t+=2){
    STEP(pB0,pB1,pA0,pA1,t,true,true,true);     WB(2,3); RESC(); ROT();
    STEP(pA0,pA1,pB0,pB1,t+1,true,true,true);   WB(2,3); RESC(); ROT();
  }
  #define ENDW(tt) do{ if((tt)+3<NT){WB(2,3);} else if((tt)+2<NT){WB(1,2);} else {WAIT_BAR(0);} }while(0)
  for(;t+1<NT;t+=2){
    STEP(pB0,pB1,pA0,pA1,t,(t+3<NT),(t+1<NT),(t+1<NT));       ENDW(t);   RESC(); ROT();
    STEP(pA0,pA1,pB0,pB1,t+1,(t+4<NT),(t+2<NT),(t+2<NT));     ENDW(t+1); RESC(); ROT();
  }
  STEP(pB0,pB1,pA0,pA1,NT-1,false,false,false); RESC();
  { float sacc=pB0[0]+pB0[1]; _Pragma("unroll") for(int r=2;r<16;++r)sacc+=pB0[r]; _Pragma("unroll") for(int r=0;r<16;++r)sacc+=pB1[r]; l_reg+=sacc;
    pw0=(u32x4){PKW(pB0,0),PKW(pB0,2),PKW(pB0,4),PKW(pB0,6)};pw1=(u32x4){PKW(pB0,8),PKW(pB0,10),PKW(pB0,12),PKW(pB0,14)};pw2=(u32x4){PKW(pB1,0),PKW(pB1,2),PKW(pB1,4),PKW(pB1,6)};pw3=(u32x4){PKW(pB1,8),PKW(pB1,10),PKW(pB1,12),PKW(pB1,14)};
    SBAR(); pv(o,vb0+sl_cur,PAF(0),PAF(1),PAF(2),PAF(3)); if constexpr(DV2) pv(o+2,vb0+(LDS_V2-LDS_V)+sl_cur,PAF(0),PAF(1),PAF(2),PAF(3)); }
  #undef PKW
  #undef PAF
  #undef VFR
  #undef PIN
  #undef MX3
  #undef GAPA
  #undef GAPB
  #undef GAPH
  #undef GAPX
  #undef EX
  #undef VRD
  #undef KRD
  #undef KRD1
  #undef V2R
  #undef STEP
  #undef ENDW
  {auto rr=__builtin_amdgcn_permlane32_swap(__float_as_uint(l_reg),__float_as_uint(l_reg),false,false);l_reg=__uint_as_float(rr[0])+__uint_as_float(rr[1]);}
  if(hi==0)wsf[32+r32]=l_reg;asm volatile("s_waitcnt lgkmcnt(0)":::"memory");
  float rli[16];
  #pragma unroll
  for(int r=0;r<16;++r)rli[r]=__builtin_amdgcn_rcpf(wsf[32+crow(r,hi)]);
  if constexpr(DV2){ float*Orw=Oraw+(long)wid*QBLK*128;
    #pragma unroll
    for(int r=0;r<16;++r){const int orow=crow(r,hi);
      #pragma unroll
      for(int d0=0;d0<4;++d0) Orw[orow*128+d0*32+r32]=o[d0][r]*rli[r];}
  } else {
  bf16*Ow=OGu+(long)wid*QBLK*1024; const bf16*Zw=SZu+(long)wid*QBLK*1024;
  { bf16*stg=(bf16*)(shm+LDS_OST)+wid*2048;
    #pragma unroll
    for(int r=0;r<16;++r){const int orow=crow(r,hi);
      #pragma unroll
      for(int d0=0;d0<2;++d0) stg[orow*64+d0*32+r32]=(bf16)(pk_bf16(o[d0][r]*rli[r],0.f)&0xffffu);}
    asm volatile("s_waitcnt lgkmcnt(0)":::"memory");
    #pragma unroll
    for(int i=0;i<4;++i){const int row=i*8+(lane>>3),ch=lane&7; const u32x4 v=*(const u32x4*)(stg+row*64+ch*8); const u32x4 z=*(const u32x4*)(Zw+(long)row*1024+ch*8); u32x4 g;
      #pragma unroll
      for(int e=0;e<4;++e){ const float a0=__uint_as_float(v[e]<<16)*__uint_as_float(z[e]<<16), a1=__uint_as_float(v[e]&0xffff0000u)*__uint_as_float(z[e]&0xffff0000u); g[e]=pk_bf16(a0,a1); }
      *(u32x4*)(Ow+(long)row*1024+ch*8)=g;} }
  }
  asm volatile("s_waitcnt lgkmcnt(0)\n\ts_barrier":::"memory");
  #undef DMA_K
  #undef DMA_V2
  #undef NEGM
  #undef WB
  #undef TMAP
  #undef DMA_V
  #undef CMASK
  #undef START
  #undef RESC
  #undef ROT
}
#undef SBAR
#undef WAIT_BAR
}

constexpr int ATT_BUF = 64 * LDT + 128 * LDT;
template <int NDB, bool NBR>
__device__ __forceinline__ void attn_pass(const int tid, const bf16_t* __restrict__ Qrow, const bf16_t* __restrict__ Kb, const bf16_t* __restrict__ Vb,
                                          int ntiles, int rs0, int qr, int qc, int rsw, const float* srpb,
                                          bf16_t* sbase, f32x16 (&O)[NDB], float& lsum_out) {
    const int lane = tid & 63, lr = lane & 31, lh = lane >> 5;
    const int lrow = tid >> 3, lpart = tid & 7;
    constexpr int NV = NDB / 2;
    bf16x8 qf[4];
#pragma unroll
    for (int s = 0; s < 4; ++s) qf[s] = *(const bf16x8*)(Qrow + s * 16);
#pragma unroll
    for (int db = 0; db < NDB; ++db)
#pragma unroll
        for (int i = 0; i < 16; ++i) O[db][i] = 0.f;
    float m = -1e30f, lsum = 0.f;
    u32x4 kreg, vreg[NV];
    auto key0_of = [&](int it) -> int { return (NBR && it >= 4) ? (CTXL + (rs0 + it - 4) * 64) : it * 64; };
    auto gload = [&](int it) {
        const int key0 = key0_of(it);
        kreg = *(const u32x4*)(Kb + (size_t)(key0 + lrow) * 64 + lpart * 8);
#pragma unroll
        for (int j = 0; j < NV; ++j) vreg[j] = *(const u32x4*)(Vb + (size_t)(lrow + 64 * j) * TT + key0 + lpart * 8);
    };
    auto swrite = [&](int buf) {
        bf16_t* sb = sbase + buf * ATT_BUF;
        *(u32x4*)(sb + lrow * LDT + lpart * 8) = kreg;
#pragma unroll
        for (int j = 0; j < NV; ++j) *(u32x4*)(sb + 64 * LDT + (lrow + 64 * j) * LDT + lpart * 8) = vreg[j];
    };
    gload(0);
    __syncthreads();
    swrite(0);
    if (ntiles > 1) gload(1);
    __syncthreads();
    const int kfo = swap23(lr) * LDT + lh * 8;
    const int vfo = 64 * LDT + lr * LDT + lh * 8;
    const int cs_ = min(max(qc - 8, 0), 48);
#pragma unroll 1
    for (int it = 0; it < ntiles; ++it) {
        if (it + 1 < ntiles) swrite((it + 1) & 1);
        if (it + 2 < ntiles) gload(it + 2);
        const bf16_t* sb = sbase + (it & 1) * ATT_BUF;
        const int kr = rs0 + it - 4;
        const bool act = !NBR || it < 4 || (kr >= rsw && kr < rsw + 8);
        if (act) {
            f32x16 S[2];
#pragma unroll
            for (int sub = 0; sub < 2; ++sub) {
#pragma unroll
                for (int i = 0; i < 16; ++i) S[sub][i] = 0.f;
#pragma unroll
                for (int s = 0; s < 4; ++s) {
                    const bf16x8 kf = *(const bf16x8*)(sb + kfo + sub * 32 * LDT + s * 16);
                    S[sub] = MFMA32(kf, qf[s], S[sub]);
                }
            }
            if (NBR && it >= 4) {
                const float* bp = srpb + (kr - qr + 7) * 31 + 15 - qc;
#pragma unroll
                for (int sub = 0; sub < 2; ++sub)
#pragma unroll
                    for (int i = 0; i < 16; ++i) {
                        const int kc = sub * 32 + (i & 7) + 8 * lh + 16 * (i >> 3);
                        const bool valid = (unsigned)(kc - cs_) < 16u;
                        const float bias = valid ? bp[kc] : 0.f;
                        S[sub][i] = valid ? S[sub][i] + bias : -1e30f;
                    }
            }
            float mx = S[0][0];
#pragma unroll
            for (int i = 1; i < 16; ++i) mx = fmaxf(mx, S[0][i]);
#pragma unroll
            for (int i = 0; i < 16; ++i) mx = fmaxf(mx, S[1][i]);
            mx = fmaxf(mx, __shfl_xor(mx, 32));
            const bool need = mx > m;
            {
                const float mnew = need ? mx : m;
                const float alpha = fast_exp2(m - mnew);
                m = mnew;
                lsum *= alpha;
#pragma unroll
                for (int db = 0; db < NDB; ++db)
#pragma unroll
                    for (int i = 0; i < 16; ++i) O[db][i] *= alpha;
            }
            float rs = 0.f;
#pragma unroll
            for (int sub = 0; sub < 2; ++sub)
#pragma unroll
                for (int i = 0; i < 16; ++i) { const float pv = fast_exp2(S[sub][i] - m); S[sub][i] = pv; rs += pv; }
            lsum += rs;
#pragma unroll
            for (int sub = 0; sub < 2; ++sub)
#pragma unroll
                for (int s2 = 0; s2 < 2; ++s2) {
                    u32x4 pw;
                    pw.x = pk_bf16(S[sub][8 * s2 + 0], S[sub][8 * s2 + 1]); pw.y = pk_bf16(S[sub][8 * s2 + 2], S[sub][8 * s2 + 3]);
                    pw.z = pk_bf16(S[sub][8 * s2 + 4], S[sub][8 * s2 + 5]); pw.w = pk_bf16(S[sub][8 * s2 + 6], S[sub][8 * s2 + 7]);
                    const bf16x8 pf = __builtin_bit_cast(bf16x8, pw);
#pragma unroll
                    for (int db = 0; db < NDB; ++db) {
                        const bf16x8 vf = *(const bf16x8*)(sb + vfo + db * 32 * LDT + (sub * 2 + s2) * 16);
                        O[db] = MFMA32(vf, pf, O[db]);
                    }
                }
        }
        __syncthreads();
    }
    lsum_out = lsum + __shfl_xor(lsum, 32);
}

template <int NDB>
__device__ __forceinline__ void attn_store(const Params& p, int row, int col0, const f32x16 (&O)[NDB], int lh) {
    const bf16_t* szr = p.sz + (size_t)row * D + col0;
    bf16_t* ogr = p.og + (size_t)row * D + col0;
#pragma unroll
    for (int db = 0; db < NDB; ++db)
#pragma unroll
        for (int g4 = 0; g4 < 4; ++g4) {
            const int d0 = db * 32 + 8 * g4 + 4 * lh;
            const u32x2 zz = *(const u32x2*)(szr + d0);
            const float z0 = __uint_as_float(zz.x << 16), z1 = __uint_as_float(zz.x & 0xffff0000u);
            const float z2 = __uint_as_float(zz.y << 16), z3 = __uint_as_float(zz.y & 0xffff0000u);
            u32x2 o; o.x = pk_bf16(O[db][4 * g4 + 0] * z0, O[db][4 * g4 + 1] * z1); o.y = pk_bf16(O[db][4 * g4 + 2] * z2, O[db][4 * g4 + 3] * z3);
            *(u32x2*)(ogr + d0) = o;
        }
}

__device__ __forceinline__ void phase_attn(const Params& p, int l, unsigned char* smem) {
    const int kind = l % 3;
    const bool need_ctx = l < 3;
    bf16_t* sbase = (bf16_t*)smem; float* srpb = (float*)(sbase + 2 * ATT_BUF);
    int tid = threadIdx.x; asm volatile("" : "+v"(tid));
    const int lane = tid & 63, w = tid >> 6, lr = lane & 31, lh = lane >> 5;
    const int b = blockIdx.x & 7, xj = blockIdx.x >> 3, xn = gridDim.x >> 3;
    if (kind == 0) {
        const int nlat = 16 * 16, nctx = need_ctx ? 16 : 0;
        for (int li = xj; li < nlat + nctx; li += xn) {
            int head, qb; const bool isctx = li >= nlat;
            if (!isctx) { qb = li & 15; head = li >> 4; } else { qb = 0; head = li - nlat; }
            const int kh = head >> 2;
            const bf16_t* Qu = p.q + (((size_t)b * 16 + head) * TT + (isctx ? 0 : CTXL + qb * 256)) * 64;
            const bf16_t* Kh = p.k + ((size_t)b * 4 + kh) * TT * 64;
            const bf16_t* Vh = p.vt + ((size_t)b * 4 + kh) * TT * 64;
            const size_t grow0 = isctx ? (size_t)MLAT + b * CTXL : (size_t)b * SEQ + qb * 256;
            attn_a::attn_unit<8>(Qu, Kh, Vh, isctx ? 4 : TT / 64, p.sz + grow0 * D + head * 64, p.og + grow0 * D + head * 64, (char*)smem);
        }
    } else if (kind == 1) {
        const int nlat = 16 * 16, nctx = need_ctx ? 16 : 0;
        LAS float* rpbL = (LAS float*)((LAS unsigned char*)smem + 90112);
        for (int li = xj; li < nlat + nctx; li += xn) {
            int head, qb; const bool isctx = li >= nlat;
            if (!isctx) { qb = li & 15; head = li >> 4; } else { qb = 0; head = li - nlat; }
            const bf16_t* Qu = p.q + (((size_t)b * 16 + head) * TT + (isctx ? 0 : CTXL + qb * 256)) * 64;
            const bf16_t* Kh = p.k + ((size_t)b * 16 + head) * TT * 64;
            const bf16_t* Vh = p.vt + ((size_t)b * 16 + head) * TT * 64;
            const size_t grow0 = isctx ? (size_t)MLAT + b * CTXL : (size_t)b * SEQ + qb * 256;
            if (!isctx) {
                const int rstart = min(min(max(4 * qb - 4, 0), 56), 52);
                for (int idx = tid; idx < 465; idx += NTHR) rpbL[idx] = p.rpb[head * 465 + idx] * LOG2E;
                attn_a::attn_unit<8, true>(Qu, Kh, Vh, 16, p.sz + grow0 * D + head * 64, p.og + grow0 * D + head * 64, (char*)smem, rstart, 4 * qb, rpbL);
            } else {
                attn_a::attn_unit<8, false>(Qu, Kh, Vh, 4, p.sz + grow0 * D + head * 64, p.og + grow0 * D + head * 64, (char*)smem);
            }
        }
    } else {
        const float lam = p.lam[0];
        const float post = 1.0f - p.lam_init;
        float* blk = p.scr + (size_t)blockIdx.x * (2 * 256 * 128);
        const int nlat = 8 * 16, nctx = need_ctx ? 8 : 0;
        for (int li = xj; li < nlat + nctx; li += xn) {
            int hh, qb; const bool isctx = li >= nlat;
            if (!isctx) { qb = li & 15; hh = li >> 4; } else { qb = 0; hh = li - nlat; }
            const int qpos0 = isctx ? 0 : CTXL + qb * 256;
            const size_t grow0 = isctx ? (size_t)MLAT + b * CTXL : (size_t)b * SEQ + qb * 256;
            const int nt = isctx ? 4 : TT / 64;
            const bf16_t* Va = p.vt + ((size_t)b * 16 + hh * 2) * TT * 64;
            const bf16_t* Vb = p.vt + ((size_t)b * 16 + hh * 2 + 1) * TT * 64;
#pragma unroll 1
            for (int mm = 0; mm < 2; ++mm) {
                const bf16_t* Qu = p.q + (((size_t)b * 16 + hh * 2 + mm) * TT + qpos0) * 64;
                const bf16_t* Kh = p.k + ((size_t)b * 16 + hh * 2 + mm) * TT * 64;
                attn_a::attn_unit<8, false, true>(Qu, Kh, Va, nt, nullptr, nullptr, (char*)smem, 0, 0, nullptr, Vb, blk + mm * (256 * 128));
            }
            __syncthreads();
            const float g0 = p.subln_g[lane * 2], g1 = p.subln_g[lane * 2 + 1];
#pragma unroll 8
            for (int i = 0; i < 32; ++i) {
                const int qrow = w * 32 + i;
                const float2 a0 = *(const float2*)(blk + (size_t)qrow * 128 + lane * 2);
                const float2 a1 = *(const float2*)(blk + (size_t)(256 + qrow) * 128 + lane * 2);
                const unsigned zz = *(const unsigned*)(p.sz + (grow0 + qrow) * D + hh * 128 + lane * 2);
                const float o0 = a0.x - lam * a1.x, o1 = a0.y - lam * a1.y;
                float ss = o0 * o0 + o1 * o1;
                ss = wave_sum64(ss);
                const float rstd = rsqrtf(ss * (1.0f / 128.0f) + EPS) * post;
                const float z0 = __uint_as_float(zz << 16), z1 = __uint_as_float(zz & 0xffff0000u);
                *(unsigned*)(p.og + (grow0 + qrow) * D + hh * 128 + lane * 2) = pk_bf16(o0 * rstd * g0 * z0, o1 * rstd * g1 * z1);
            }
            __syncthreads();
        }
    }
}

__device__ __forceinline__ void grid_barrier(unsigned* ctr, unsigned target) {
    asm volatile("s_waitcnt vmcnt(0)" ::: "memory");
    __syncthreads();
    if (threadIdx.x == 0) {
        __builtin_amdgcn_fence(__ATOMIC_RELEASE, "agent");
        asm volatile("s_waitcnt vmcnt(0)" ::: "memory");
        __hip_atomic_fetch_add(ctr, 1u, __ATOMIC_RELAXED, __HIP_MEMORY_SCOPE_AGENT);
        while (__hip_atomic_load(ctr, __ATOMIC_RELAXED, __HIP_MEMORY_SCOPE_AGENT) < target) __builtin_amdgcn_s_sleep(1);
        __builtin_amdgcn_fence(__ATOMIC_ACQUIRE, "agent");
        asm volatile("s_waitcnt vmcnt(0)" ::: "memory");
    }
    __syncthreads();
}

__device__ __forceinline__ void group_barrier(unsigned* bar, unsigned target) {
    grid_barrier(bar + 64 * (1 + (blockIdx.x & 7)), target);
}

__global__ void __launch_bounds__(NTHR, 2) fwd_kernel(Params p) {
    extern __shared__ __attribute__((aligned(16))) unsigned char smem[];
    cg::grid_group grid = cg::this_grid();
    phase0(p, smem);
    if (p.lam_init < -1.0e30f) grid.sync();
    grid_barrier(p.bar, gridDim.x);
    unsigned tgt = 0;
    const unsigned nb = gridDim.x >> 3;
    phase_prep(p, 0, 0);
    tgt += nb; group_barrier(p.bar, tgt);
#pragma unroll 1
    for (int l = 0; l < 4; ++l) {
        phase_inproj(p, l, smem);
        tgt += nb; group_barrier(p.bar, tgt);
        phase_attn(p, l, smem);
        tgt += nb; group_barrier(p.bar, tgt);
        const int nst = l < 3 ? 3 : 1;
#pragma unroll 1
        for (int st = 0; st < nst; ++st) {
            const bool do_out = st == 0 || (st == 1 && (blockIdx.x >> 3) < 4);
            if (do_out) phase_outproj(p, l, st == 1, smem);
            else phase_prep(p, l + 1, st);
            if (l < 3) { tgt += nb; group_barrier(p.bar, tgt); }
        }
    }
}

extern "C" void kernel_launch(void* const* d_in, const int* in_sizes, int n_in, void* d_out, int out_size, void* d_ws, size_t ws_size,
                              hipStream_t stream) {
    static int grid_blocks = 0;
    if (!grid_blocks) {
        int dev = 0, cus = 0;
        (void)hipGetDevice(&dev);
        (void)hipDeviceGetAttribute(&cus, hipDeviceAttributeMultiprocessorCount, dev);
        if (hipFuncSetAttribute((const void*)fwd_kernel, hipFuncAttributeMaxDynamicSharedMemorySize, LDS_BYTES) != hipSuccess)
            fprintf(stderr, "hipFuncSetAttribute(max dynamic LDS) failed\n");
        (void)hipGetLastError();
        grid_blocks = cus > 0 ? (cus & ~7) : 256;
    }
    Params p{};
    p.x = (const float*)d_in[0]; p.c = (const float*)d_in[1]; p.ctx = (const float*)d_in[2]; p.c_ctx = (const float*)d_in[3];
    p.norm_g = (const float*)d_in[4]; p.ada_w = (const float*)d_in[5]; p.ada_b = (const float*)d_in[6];
    const float* a_w_in = (const float*)d_in[7]; const float* a_q_g = (const float*)d_in[8]; const float* a_k_g = (const float*)d_in[9];
    const float* a_w_out = (const float*)d_in[10];
    const float* b_w_in = (const float*)d_in[11]; const float* b_q_g = (const float*)d_in[12]; const float* b_k_g = (const float*)d_in[13];
    const float* b_w_out = (const float*)d_in[15];
    const float* c_w_in = (const float*)d_in[16]; const float* c_q_g = (const float*)d_in[17]; const float* c_k_g = (const float*)d_in[18];
    const float* c_w_out = (const float*)d_in[24];
    p.w_in[0] = a_w_in; p.w_in[1] = b_w_in; p.w_in[2] = c_w_in; p.w_in[3] = a_w_in + (size_t)1024 * 2560;
    p.w_out[0] = a_w_out; p.w_out[1] = b_w_out; p.w_out[2] = c_w_out; p.w_out[3] = a_w_out + (size_t)1024 * 1024;
    p.q_g[0] = a_q_g; p.q_g[1] = b_q_g; p.q_g[2] = c_q_g; p.q_g[3] = a_q_g + 64;
    p.k_g[0] = a_k_g; p.k_g[1] = b_k_g; p.k_g[2] = c_k_g; p.k_g[3] = a_k_g + 64;
    p.rpb = (const float*)d_in[14];
    p.lq1 = (const float*)d_in[19]; p.lk1 = (const float*)d_in[20]; p.lq2 = (const float*)d_in[21]; p.lk2 = (const float*)d_in[22];
    p.subln_g = (const float*)d_in[23];
    p.out = (float*)d_out;
    char* ws = (char*)d_ws; size_t off = 0;
    auto take = [&](size_t bytes) { char* r = ws + off; off += (bytes + 255) & ~(size_t)255; return r; };
    p.xb = (float*)take((size_t)MCTX * D * 4);
    p.h = (bf16_t*)take((size_t)MTOT * D * 2);
    p.q = (bf16_t*)take((size_t)NB * 16 * TT * 64 * 2);
    p.k = (bf16_t*)take((size_t)NB * 16 * TT * 64 * 2);
    p.vt = (bf16_t*)take((size_t)NB * 1024 * TT * 2);
    p.sz = (bf16_t*)take((size_t)MTOT * D * 2);
    p.og = p.h;
    for (int l = 0; l < 4; ++l) { const int N = (l == 0 || l == 3) ? 2560 : 4096; p.wt_in[l] = (bf16_t*)take((size_t)N * 1024 * 2); }
    for (int l = 0; l < 4; ++l) p.wt_out[l] = (bf16_t*)take((size_t)1024 * 1024 * 2);
    p.mod = (float*)take((size_t)4 * 9 * 3072 * 4);
    p.rope = (float*)take(64 * 16 * 2 * 4);
    p.lam = (float*)take(256);
    p.bar = (unsigned*)take(4096);
    p.scr = (float*)take((size_t)256 * 2 * 256 * 128 * 4);
    if (off > ws_size) { fprintf(stderr, "workspace too small: need %zu have %zu\n", off, ws_size); return; }
    p.lam_init = (float)(0.8 - 0.6 * std::exp(-0.3 * 2.0));
    p.pad0 = 0.f;
    void* args[] = {&p};
    if (hipMemsetAsync(p.bar, 0, 4096, stream) != hipSuccess) fprintf(stderr, "hipMemsetAsync of the barrier words failed\n");
    hipError_t e = hipLaunchCooperativeKernel((void*)fwd_kernel, dim3(grid_blocks), dim3(NTHR), args, LDS_BYTES, stream);
    if (e != hipSuccess) fprintf(stderr, "cooperative launch failed: %s (grid %d)\n", hipGetErrorString(e), grid_blocks);
}
```

```cpp
#include <hip/hip_runtime.h>
#include <hip/hip_cooperative_groups.h>
#include <cstdio>
#include <cmath>
namespace cg = cooperative_groups;

typedef unsigned short bf16_t;
constexpr float LOG2E_ = 1.4426950408889634f;
typedef short bf16x8 __attribute__((ext_vector_type(8)));
typedef float f32x16 __attribute__((ext_vector_type(16)));
typedef float f32x4 __attribute__((ext_vector_type(4)));
typedef unsigned u32x4 __attribute__((ext_vector_type(4)));
typedef unsigned u32x2 __attribute__((ext_vector_type(2)));
#define LAS __attribute__((address_space(3)))

#define MFMA32(a, b, c) __builtin_amdgcn_mfma_f32_32x32x16_bf16((a), (b), (c), 0, 0, 0)

constexpr int D = 1024, NB = 8, SEQ = 4096, CTXL = 256, TT = SEQ + CTXL;
constexpr int MLAT = NB * SEQ, MCTX = NB * CTXL, MTOT = MLAT + MCTX;
constexpr int LDT = 72;
constexpr int NTHR = 512;
constexpr int LDS_BYTES = 158208;
constexpr float LOG2E = 1.4426950408889634f;
constexpr float QSCALE = 0.125f * LOG2E;
constexpr float EPS = 1e-6f;

__constant__ float INVF[16] = {1.0f, 0.5623413324356079f, 0.3162277638912201f, 0.17782793939113617f, 0.10000000149011612f,
    0.05623413249850273f, 0.03162277489900589f, 0.017782794311642647f, 0.009999999776482582f, 0.005623413249850273f,
    0.003162277629598975f, 0.0017782794311642647f, 0.0010000000474974513f, 0.000562341301701963f, 0.0003162277571391314f,
    0.00017782794020604342f};

struct Params {
    const float *x, *c, *ctx, *c_ctx, *norm_g, *ada_w, *ada_b;
    const float* w_in[4]; const float* w_out[4]; const float* q_g[4]; const float* k_g[4];
    const float *rpb, *lq1, *lk1, *lq2, *lk2, *subln_g;
    float* out;
    float* xb;
    bf16_t *h, *q, *k, *vt, *sz, *og;
    bf16_t* wt_in[4]; bf16_t* wt_out[4];
    float *mod, *rope, *lam, *scr;
    unsigned* bar;
    float lam_init; float pad0;
};

__device__ __forceinline__ unsigned pk_bf16(float lo, float hi) {
    unsigned r; asm("v_cvt_pk_bf16_f32 %0, %1, %2" : "=v"(r) : "v"(lo), "v"(hi)); return r;
}
__device__ __forceinline__ int swap23(int x) { return (x & 0x13) | ((x & 4) << 1) | ((x & 8) >> 1); }
__device__ __forceinline__ float fast_exp2(float x) { return __builtin_amdgcn_exp2f(x); }
__device__ __forceinline__ float wave_sum64(float v) {
    v += __uint_as_float(__builtin_amdgcn_mov_dpp(__float_as_uint(v), 0xB1, 0xF, 0xF, true));
    v += __uint_as_float(__builtin_amdgcn_mov_dpp(__float_as_uint(v), 0x4E, 0xF, 0xF, true));
    v += __uint_as_float(__builtin_amdgcn_mov_dpp(__float_as_uint(v), 0x141, 0xF, 0xF, true));
    v += __uint_as_float(__builtin_amdgcn_mov_dpp(__float_as_uint(v), 0x140, 0xF, 0xF, true));
    { auto rr = __builtin_amdgcn_permlane16_swap(__float_as_uint(v), __float_as_uint(v), false, false); v = __uint_as_float(rr[0]) + __uint_as_float(rr[1]); }
    { auto rr = __builtin_amdgcn_permlane32_swap(__float_as_uint(v), __float_as_uint(v), false, false); v = __uint_as_float(rr[0]) + __uint_as_float(rr[1]); }
    return v;
}
__device__ __forceinline__ float silu_f(float z) { return z * __builtin_amdgcn_rcpf(1.0f + __builtin_amdgcn_exp2f(-LOG2E_ * z)); }
template <typename T> __device__ __forceinline__ T sel4(T const (&a)[4], int l) { return l == 0 ? a[0] : (l == 1 ? a[1] : (l == 2 ? a[2] : a[3])); }
__host__ __device__ __forceinline__ int layer_N(int l) { return (l == 0 || l == 3) ? 2560 : 4096; }

namespace pg8 {
constexpr int BM = 256, BK = 64, HALF = 128, HTB = HALF * BK * 2, STAGE_BYTES = 8 * HTB;
__device__ __forceinline__ int lds_byte(int r, int c) { const int st = (r >> 4) * 2 + (c >> 5), rr = r & 15, cc = c & 31, ob = rr * 64 + cc * 2; return st * 1024 + (ob ^ (((ob >> 9) & 1) << 5)); }
__device__ __forceinline__ void stage_rc(int b, int& R, int& C) { const int st = b / 1024, sb = b % 1024, swz = sb ^ (((sb >> 9) & 1) << 5); R = (st >> 1) * 16 + swz / 64; C = (st & 1) * 32 + (swz % 64) / 2; }

struct Unit { const char* a; const char* b; int pm, pn, kind; };

template <class Epi, class Sched>
__device__ __forceinline__ void gemm_phase(LAS unsigned char* lds, const int K, const Sched& S, const Epi& E) {
    int tid = threadIdx.x; asm volatile("" : "+v"(tid));
    const int wid = __builtin_amdgcn_readfirstlane(tid >> 6), lane = tid & 63, wr = wid >> 2, wc = wid & 3, fr = lane & 15, fq = lane >> 4;
    const int nt = K / BK;
    unsigned voffA[2];
#pragma unroll
    for (int i = 0; i < 2; ++i) { int R, C; stage_rc(tid * 16 + i * 8192, R, C); voffA[i] = (unsigned)(R * K + C) * 2u; }
    const size_t kstep = (size_t)(BK * 2);
    const size_t hstep = (size_t)HALF * K * 2;
    const unsigned ldsw = (unsigned)wid * 1024u;
    const int aoff = lds_byte(wr * 64 + fr, fq * 8), boff = lds_byte(wc * 32 + fr, fq * 8);
#define PG8_SA(b, h) (((b) * 2 + (h)) * HTB)
#define PG8_SB(b, h) ((4 + (b) * 2 + (h)) * HTB)
#define PG8_STAGE(bufoff, gbase, voff) do { _Pragma("unroll") for (int _i = 0; _i < 2; ++_i) \
        __builtin_amdgcn_global_load_lds((const unsigned*)((const char*)(gbase) + (voff)[_i]), (LAS unsigned*)(lds + (bufoff) + ldsw + _i * 8192), 16, 0, 0); } while (0)
#define PG8_LDA(dst, b, h) do { _Pragma("unroll") for (int m = 0; m < 4; ++m) _Pragma("unroll") for (int k = 0; k < 2; ++k) dst[m][k] = *(const LAS bf16x8*)(lds + PG8_SA(b, h) + aoff + m * 2048 + k * 1024); } while (0)
#define PG8_LDB(dst, b, h) do { _Pragma("unroll") for (int n = 0; n < 2; ++n) _Pragma("unroll") for (int k = 0; k < 2; ++k) dst[n][k] = *(const LAS bf16x8*)(lds + PG8_SB(b, h) + boff + n * 2048 + k * 1024); } while (0)
#define PG8_MMA(ai, bj, At, Bt) do { __builtin_amdgcn_s_setprio(1); _Pragma("unroll") for (int m = 0; m < 4; ++m) _Pragma("unroll") for (int n = 0; n < 2; ++n) _Pragma("unroll") for (int k = 0; k < 2; ++k) \
        acc[ai][bj][m][n] = __builtin_amdgcn_mfma_f32_16x16x32_bf16(Bt[n][k], At[m][k], acc[ai][bj][m][n], 0, 0, 0); __builtin_amdgcn_s_setprio(0); } while (0)
#define PG8_WAIT_V(n) asm volatile("s_waitcnt vmcnt(" #n ")" ::: "memory")
#define PG8_WAIT_L(n) asm volatile("s_waitcnt lgkmcnt(" #n ")" ::: "memory")
#define PG8_BAR __builtin_amdgcn_s_barrier()
#define PG8_SCHED __builtin_amdgcn_sched_barrier(0)
    Unit cur, nxt; int ui = 0;
    if (!S.next(0, cur)) return;
    f32x4 acc[2][2][4][2];
#pragma unroll
    for (int a = 0; a < 2; ++a)
#pragma unroll
        for (int b = 0; b < 2; ++b)
#pragma unroll
            for (int m = 0; m < 4; ++m)
#pragma unroll
                for (int n = 0; n < 2; ++n) acc[a][b][m][n] = (f32x4){0.f, 0.f, 0.f, 0.f};
    bf16x8 At[4][2], B0[2][2], B1[2][2];
    const char* cA = cur.a; const char* cB = cur.b;
    {
        PG8_STAGE(PG8_SB(0, 0), cB, voffA); PG8_STAGE(PG8_SB(0, 1), cB + hstep, voffA); PG8_STAGE(PG8_SA(0, 0), cA, voffA); PG8_STAGE(PG8_SA(0, 1), cA + hstep, voffA);
        if (wr == 1) PG8_BAR;
        PG8_WAIT_V(2); PG8_BAR;
        PG8_STAGE(PG8_SB(1, 0), cB + kstep, voffA); PG8_STAGE(PG8_SA(1, 0), cA + kstep, voffA); PG8_STAGE(PG8_SB(1, 1), cB + hstep + kstep, voffA);
        PG8_WAIT_V(6); PG8_BAR;
    }
    for (;;) {
        const bool has_next = S.next(ui + 1, nxt);
        const char* nA = has_next ? nxt.a : cA; const char* nB = has_next ? nxt.b : cB;
        for (int t = 0; t < nt; t += 2) {
            const bool last = (t == nt - 2);
            const char* a1 = cA + (size_t)(t + 1) * kstep;
            const char* a2 = last ? nA : cA + (size_t)(t + 2) * kstep; const char* b2 = last ? nB : cB + (size_t)(t + 2) * kstep;
            const char* a3 = a2 + kstep; const char* b3 = b2 + kstep;
            PG8_LDB(B0, 0, 0); PG8_LDB(B1, 0, 1); PG8_SCHED; PG8_LDA(At, 0, 0); PG8_STAGE(PG8_SA(1, 1), a1 + hstep, voffA);
            PG8_WAIT_V(8); PG8_WAIT_L(0); PG8_BAR; PG8_MMA(0, 0, At, B0); PG8_MMA(0, 1, At, B1); PG8_BAR; PG8_SCHED;
            PG8_LDA(At, 0, 1); PG8_STAGE(PG8_SB(0, 0), b2, voffA); PG8_STAGE(PG8_SB(0, 1), b2 + hstep, voffA); PG8_STAGE(PG8_SA(0, 0), a2, voffA);
            PG8_WAIT_V(8); PG8_WAIT_L(0); PG8_BAR; PG8_MMA(1, 0, At, B0); PG8_MMA(1, 1, At, B1); PG8_BAR; PG8_SCHED;
            PG8_LDB(B0, 1, 0); PG8_LDB(B1, 1, 1); PG8_SCHED; PG8_LDA(At, 1, 0); PG8_STAGE(PG8_SA(0, 1), a2 + hstep, voffA);
            PG8_WAIT_V(8); PG8_WAIT_L(0); PG8_BAR; PG8_MMA(0, 0, At, B0); PG8_MMA(0, 1, At, B1); PG8_BAR; PG8_SCHED;
            PG8_LDA(At, 1, 1); PG8_STAGE(PG8_SB(1, 0), b3, voffA); PG8_STAGE(PG8_SB(1, 1), b3 + hstep, voffA); PG8_STAGE(PG8_SA(1, 0), a3, voffA);
            PG8_WAIT_V(8); PG8_WAIT_L(0); PG8_BAR; PG8_MMA(1, 0, At, B0); PG8_MMA(1, 1, At, B1); PG8_BAR; PG8_SCHED;
        }
        if (wr == 0) PG8_BAR;
        E(acc, cur, wr, wc, fr, fq);
        if (!has_next) break;
#pragma unroll
        for (int a = 0; a < 2; ++a)
#pragma unroll
            for (int b = 0; b < 2; ++b)
#pragma unroll
                for (int m = 0; m < 4; ++m)
#pragma unroll
                    for (int n = 0; n < 2; ++n) acc[a][b][m][n] = (f32x4){0.f, 0.f, 0.f, 0.f};
        cur = nxt; cA = nA; cB = nB; ++ui;
        if (wr == 1) PG8_BAR;
    }
    PG8_WAIT_V(0);
    PG8_BAR;
#undef PG8_SA
#undef PG8_SB
#undef PG8_STAGE
#undef PG8_LDA
#undef PG8_LDB
#undef PG8_MMA
#undef PG8_WAIT_V
#undef PG8_WAIT_L
#undef PG8_BAR
#undef PG8_SCHED
}
}

__device__ __forceinline__ bool xcd_unit(int i, int MT, int NU, int& mt, int& un) {
    int bx = blockIdx.x, gx = gridDim.x;
    asm volatile("" : "+s"(NU), "+s"(MT), "+s"(bx), "+s"(gx));
    const int xcd = bx & 7, j = bx >> 3, nbx = gx >> 3;
    const int mcount = MT >> 3;
    const int q = j + i * nbx;
    if (q >= mcount * NU) return false;
    const int g = q / (8 * NU), r = q - g * 8 * NU;
    const int gsz = min(8, mcount - g * 8);
    const int ml = g * 8 + r % gsz; un = r / gsz;
    mt = ml < 16 ? 16 * xcd + ml : MLAT / 256 + xcd;
    return true;
}

__device__ __forceinline__ void phase0(const Params& p, unsigned char* smem) {
    int tid = threadIdx.x; asm volatile("" : "+v"(tid));
    constexpr int N_ADA = 192, N_WT = 4352;
    for (int item = blockIdx.x; item < N_ADA + N_WT + 1; item += gridDim.x) {
        if (item < N_ADA) {
            float* ssc = (float*)smem;
            float* red = ssc + 9 * 1024;
            const int l = item / 48, n0 = (item % 48) * 64;
            __syncthreads();
            for (int idx = tid; idx < 9 * 1024; idx += NTHR) {
                const int v = idx >> 10, kk = idx & 1023;
                const float cv = v < 8 ? p.c[v * 1024 + kk] : p.c_ctx[kk];
                ssc[idx] = cv / (1.0f + expf(-cv));
            }
            __syncthreads();
            const int kg = tid >> 6, col = tid & 63;
            float acc[9];
#pragma unroll
            for (int v = 0; v < 9; ++v) acc[v] = 0.f;
            const float* wp = p.ada_w + ((size_t)l * 1024 + kg * 128) * 3072 + n0 + col;
#pragma unroll 2
            for (int kk = 0; kk < 128; kk += 4) {
                const float w0 = wp[(size_t)(kk + 0) * 3072], w1 = wp[(size_t)(kk + 1) * 3072], w2 = wp[(size_t)(kk + 2) * 3072], w3 = wp[(size_t)(kk + 3) * 3072];
#pragma unroll
                for (int v = 0; v < 9; ++v) {
                    const float4 sv = *(const float4*)(ssc + v * 1024 + kg * 128 + kk);
                    acc[v] += sv.x * w0 + sv.y * w1 + sv.z * w2 + sv.w * w3;
                }
            }
#pragma unroll
            for (int v = 0; v < 9; ++v) red[(kg * 9 + v) * 64 + col] = acc[v];
            __syncthreads();
            for (int idx = tid; idx < 9 * 64; idx += NTHR) {
                const int v = idx >> 6, cc = idx & 63;
                float s = 0.f;
#pragma unroll
                for (int g = 0; g < 8; ++g) s += red[(g * 9 + v) * 64 + cc];
                s += p.ada_b[l * 3072 + n0 + cc];
                p.mod[((size_t)l * 9 + v) * 3072 + n0 + cc] = s;
            }
        } else if (item < N_ADA + N_WT) {
            int t = item - N_ADA;
            const float* W; bf16_t* Wt; int N; int nperm = 0;
            int l = 0; bool found = false;
#pragma unroll
            for (int m = 0; m < 4; ++m) {
                const int ntl = 16 * (layer_N(m) / 64);
                if (!found) { if (t < ntl) { l = m; found = true; } else t -= ntl; }
            }
            if (found) { W = sel4(p.w_in, l); Wt = sel4(p.wt_in, l); N = layer_N(l); nperm = 1024 + ((l == 0 || l == 3) ? 256 : 1024); }
            else { l = t / 256; t = t % 256; W = sel4(p.w_out, l); Wt = sel4(p.wt_out, l); N = 1024; }
            const int k0 = (t & 15) * 64, n0 = (t >> 4) * 64;
            float* sT = (float*)smem;
            float4 v[2];
#pragma unroll
            for (int i = 0; i < 2; ++i) {
                const int kk = (tid >> 4) + 32 * i, n4 = (tid & 15) * 4;
                v[i] = *(const float4*)(W + (size_t)(k0 + kk) * N + n0 + n4);
            }
            __syncthreads();
#pragma unroll
            for (int i = 0; i < 2; ++i) {
                const int kk = (tid >> 4) + 32 * i, n4 = (tid & 15) * 4;
                sT[(n4 + 0) * 65 + kk] = v[i].x; sT[(n4 + 1) * 65 + kk] = v[i].y;
                sT[(n4 + 2) * 65 + kk] = v[i].z; sT[(n4 + 3) * 65 + kk] = v[i].w;
            }
            __syncthreads();
            {
                const int n = tid >> 3, k8 = (tid & 7) * 8;
                const float* s = sT + n * 65 + k8;
                u32x4 o; o.x = pk_bf16(s[0], s[1]); o.y = pk_bf16(s[2], s[3]); o.z = pk_bf16(s[4], s[5]); o.w = pk_bf16(s[6], s[7]);
                int f = n0 + n;
                if (f < nperm) { const int fl = f & 255, hh = fl >> 6, d = fl & 63; f = (f & ~255) + 128 * (d >> 5) + 32 * hh + (d & 31); }
                *(u32x4*)(Wt + (size_t)f * 1024 + k0 + k8) = o;
            }
        } else {
            for (int idx = tid; idx < 1024; idx += NTHR) {
                const int pos = idx >> 4, f = idx & 15;
                const float angf = (float)pos * INVF[f];
                const double a = (double)angf;
                const double kq = rint(a * 0.63661977236758134308);
                const double r = a - kq * 1.57079632679489661923;
                const double r2 = r * r;
                double sn = r * (1.0 + r2 * (-1.0 / 6 + r2 * (1.0 / 120 + r2 * (-1.0 / 5040 + r2 * (1.0 / 362880 + r2 * (-1.0 / 39916800 + r2 * (1.0 / 6227020800.0)))))));
                double cs = 1.0 + r2 * (-0.5 + r2 * (1.0 / 24 + r2 * (-1.0 / 720 + r2 * (1.0 / 40320 + r2 * (-1.0 / 3628800 + r2 * (1.0 / 479001600.0))))));
                const int qd = ((int)kq) & 3;
                double so, co;
                if (qd == 0) { so = sn; co = cs; } else if (qd == 1) { so = cs; co = -sn; } else if (qd == 2) { so = -sn; co = -cs; } else { so = -cs; co = sn; }
                p.rope[idx * 2 + 0] = (float)co; p.rope[idx * 2 + 1] = (float)so;
            }
            if (tid == 0) {
                float d1 = 0.f, d2 = 0.f;
                for (int i = 0; i < 64; ++i) { d1 += p.lq1[i] * p.lk1[i]; d2 += p.lq2[i] * p.lk2[i]; }
                p.lam[0] = expf(d1) - expf(d2) + p.lam_init;
            }
        }
    }
}

__device__ __forceinline__ const float* xin_row(const Params& p, int l, int row) {
    if (l == 0) return row < MLAT ? p.x + (size_t)row * D : p.ctx + (size_t)(row - MLAT) * D;
    return row < MLAT ? p.out + (size_t)row * D : p.xb + (size_t)(row - MLAT) * D;
}

__device__ __forceinline__ void phase_prep(const Params& p, int l, int mode) {
    asm volatile("" : "+s"(l), "+s"(mode));
    int tid = threadIdx.x; asm volatile("" : "+v"(tid));
    const int lane = tid & 63, w = tid >> 6;
    const float* g = p.norm_g + l * D;
    const int xb_ = blockIdx.x & 7, xj_ = (int)(blockIdx.x >> 3) - (mode == 1 ? 4 : 0), xn_ = (int)(gridDim.x >> 3) - (mode == 1 ? 4 : 0);
    const int lr_lo = mode == 2 ? SEQ : 0, lr_hi = mode == 1 ? SEQ : SEQ + CTXL;
    for (int lrow = lr_lo + xj_ * 8 + w; lrow < lr_hi; lrow += xn_ * 8) {
        const int row = lrow < SEQ ? xb_ * SEQ + lrow : MLAT + xb_ * CTXL + (lrow - SEQ);
        const float* xr = xin_row(p, l, row);
        const int bv = row < MLAT ? (row >> 12) : 8;
        const float* md = p.mod + ((size_t)l * 9 + bv) * 3072;
        float4 v[4]; float ss = 0.f;
#pragma unroll
        for (int j = 0; j < 4; ++j) {
            v[j] = *(const float4*)(xr + j * 256 + lane * 4);
            ss += v[j].x * v[j].x + v[j].y * v[j].y + v[j].z * v[j].z + v[j].w * v[j].w;
        }
#pragma unroll
        for (int o = 32; o >= 1; o >>= 1) ss += __shfl_xor(ss, o);
        const float rstd = rsqrtf(ss * (1.0f / 1024.0f) + EPS);
#pragma unroll
        for (int j = 0; j < 4; ++j) {
            const int col = j * 256 + lane * 4;
            const float4 gg = *(const float4*)(g + col);
            const float4 sh = *(const float4*)(md + col);
            const float4 sc = *(const float4*)(md + 1024 + col);
            const float a0 = v[j].x * rstd * gg.x * (1.0f + sc.x) + sh.x;
            const float a1 = v[j].y * rstd * gg.y * (1.0f + sc.y) + sh.y;
            const float a2 = v[j].z * rstd * gg.z * (1.0f + sc.z) + sh.z;
            const float a3 = v[j].w * rstd * gg.w * (1.0f + sc.w) + sh.w;
            u32x2 o; o.x = pk_bf16(a0, a1); o.y = pk_bf16(a2, a3);
            *(u32x2*)(p.h + (size_t)row * D + col) = o;
        }
    }
}

struct InSched {
    const char* h; const char* wt; int nK, NU; bool vrow;
    __device__ __forceinline__ bool next(int i, pg8::Unit& u) const {
        int mt, un;
        if (!xcd_unit(i, MTOT / 256, NU, mt, un)) return false;
        u.pm = mt; u.pn = un;
        const char* hp = h + (size_t)mt * 256 * D * 2;
        const char* wp = wt + (size_t)un * 256 * D * 2;
        const int kind = un < 4 ? 0 : (un < 4 + nK ? 1 : (un < 4 + 2 * nK ? 2 : 3));
        u.kind = (kind == 2 && vrow) ? 4 : kind;
        if (u.kind == 2) { u.a = wp; u.b = hp; } else { u.a = hp; u.b = wp; }
        return true;
    }
};

struct EpiIn {
    const LAS float* ropeL; const LAS float* gL; bf16_t *q, *k, *vt, *sz; int nK; bool do_rope; LAS unsigned char* stg0;
    __device__ __forceinline__ void operator()(const f32x4 (&acc)[2][2][4][2], const pg8::Unit& u, int wr, int wc, int fr, int fq) const {
        const int row0 = u.pm * 256;
        const bool isctx = row0 >= MLAT;
        int b, t0, pos0;
        if (!isctx) { b = row0 >> 12; t0 = row0 & 4095; pos0 = CTXL + t0; } else { b = (row0 - MLAT) >> 8; t0 = 0; pos0 = 0; }
        const int lane = fr + 16 * fq, wid = wr * 4 + wc;
        LAS unsigned char* stg = stg0 + wid * 2304;
        LAS unsigned char* wp = stg + fr * 144 + fq * 8;
        const int rr = lane >> 2, ch = lane & 3;
        const LAS unsigned char* rp = stg + rr * 144 + ch * 32;
        bf16_t* dbase; size_t rpitch; int coff;
        const int kind = u.kind;
        if (kind == 3) { dbase = sz + (size_t)row0 * D + (u.pn - 4 - 2 * nK) * 256 + wc * 32; rpitch = D; coff = (ch >> 1) * 128 + (ch & 1) * 16; }
        else if (kind == 4) { const int VH = nK * 4; const int vh = (u.pn - 4 - nK) * 4 + (wc >> 1) + 2 * (ch >> 1);
            dbase = vt + (((size_t)b * VH + vh) * TT + pos0) * 64 + (wc & 1) * 32; rpitch = 64; coff = (ch & 1) * 16; }
        else if (kind == 2) { const int VF = nK * 256;
            dbase = vt + ((size_t)b * VF + (u.pn - 4 - nK) * 256) * TT + pos0 + wc * 32; rpitch = TT; coff = (ch >> 1) * 128 + (ch & 1) * 16; }
        else { const bool isq = kind == 0; const int head = isq ? u.pn * 4 + wc : (u.pn - 4) * 4 + wc;
            dbase = (isq ? q + ((size_t)b * 16 + head) * TT * 64 : k + ((size_t)b * (nK * 4) + head) * TT * 64) + (size_t)pos0 * 64; rpitch = 64; coff = ch * 16; }
        const LAS float* gp = gL + (kind == 0 ? 0 : 64);
        const float osc = kind == 0 ? QSCALE : 1.0f;
        const bool rp_on = do_rope && !isctx;
        f32x4 g4[2][2], rc[2][2], ccur[2], cnxt[2];
        if (kind <= 1) {
#pragma unroll
            for (int bj = 0; bj < 2; ++bj)
#pragma unroll
                for (int n = 0; n < 2; ++n) g4[bj][n] = *(const LAS f32x4*)(gp + 32 * bj + 16 * n + 4 * fq);
#pragma unroll
            for (int ai = 0; ai < 2; ++ai) {
                const int pos = ((t0 >> 6) + 2 * ai + wr) & 63;
                rc[ai][0] = *(const LAS f32x4*)(ropeL + (pos * 16 + 4 * fq) * 2); rc[ai][1] = *(const LAS f32x4*)(ropeL + (pos * 16 + 4 * fq) * 2 + 4);
            }
            ccur[0] = *(const LAS f32x4*)(ropeL + (fr * 16 + 4 * fq) * 2); ccur[1] = *(const LAS f32x4*)(ropeL + (fr * 16 + 4 * fq) * 2 + 4);
        }
#pragma unroll
        for (int m = 0; m < 4; ++m) {
            if (kind <= 1 && m < 3) { const int pos = (m + 1) * 16 + fr; cnxt[0] = *(const LAS f32x4*)(ropeL + (pos * 16 + 4 * fq) * 2); cnxt[1] = *(const LAS f32x4*)(ropeL + (pos * 16 + 4 * fq) * 2 + 4); }
#pragma unroll
            for (int ai = 0; ai < 2; ++ai) {
                const int tl = ai * 128 + wr * 64 + m * 16;
                u32x2 o[2][2];
                if (kind == 3) {
#pragma unroll
                    for (int bj = 0; bj < 2; ++bj)
#pragma unroll
                        for (int n = 0; n < 2; ++n) { const f32x4 v = acc[ai][bj][m][n]; o[bj][n].x = pk_bf16(silu_f(v[0]), silu_f(v[1])); o[bj][n].y = pk_bf16(silu_f(v[2]), silu_f(v[3])); }
                } else if (kind >= 2) {
#pragma unroll
                    for (int bj = 0; bj < 2; ++bj)
#pragma unroll
                        for (int n = 0; n < 2; ++n) { const f32x4 v = acc[ai][bj][m][n]; o[bj][n].x = pk_bf16(v[0], v[1]); o[bj][n].y = pk_bf16(v[2], v[3]); }
                } else {
                    float ss = 0.f;
#pragma unroll
                    for (int bj = 0; bj < 2; ++bj)
#pragma unroll
                        for (int n = 0; n < 2; ++n) { const f32x4 v = acc[ai][bj][m][n]; ss += v[0] * v[0] + v[1] * v[1] + v[2] * v[2] + v[3] * v[3]; }
                    ss += __shfl_xor(ss, 16); ss += __shfl_xor(ss, 32);
                    const float rstd = rsqrtf(ss * (1.0f / 64.0f) + EPS);
#pragma unroll
                    for (int bj = 0; bj < 2; ++bj) {
                        f32x4 x1 = acc[ai][bj][m][0] * rstd * g4[bj][0];
                        f32x4 x2 = acc[ai][bj][m][1] * rstd * g4[bj][1];
                        {
                            const f32x4 cs0 = bj == 0 ? rc[ai][0] : ccur[0], cs1 = bj == 0 ? rc[ai][1] : ccur[1];
                            f32x4 cc = (f32x4){cs0[0], cs0[2], cs1[0], cs1[2]}, sn = (f32x4){cs0[1], cs0[3], cs1[1], cs1[3]};
                            if (!rp_on) { cc = (f32x4){1.f, 1.f, 1.f, 1.f}; sn = (f32x4){0.f, 0.f, 0.f, 0.f}; }
                            const f32x4 y1 = x1 * cc - x2 * sn, y2 = x2 * cc + x1 * sn;
                            x1 = y1; x2 = y2;
                        }
                        x1 = x1 * osc; x2 = x2 * osc;
                        o[bj][0].x = pk_bf16(x1[0], x1[1]); o[bj][0].y = pk_bf16(x1[2], x1[3]); o[bj][1].x = pk_bf16(x2[0], x2[1]); o[bj][1].y = pk_bf16(x2[2], x2[3]);
                    }
                }
#pragma unroll
                for (int bj = 0; bj < 2; ++bj)
#pragma unroll
                    for (int n = 0; n < 2; ++n) *(LAS u32x2*)(wp + (32 * bj + 16 * n) * 2) = o[bj][n];
                const u32x4 r0 = *(const LAS u32x4*)(rp), r1 = *(const LAS u32x4*)(rp + 16);
                bf16_t* dp = dbase + (size_t)(tl + rr) * rpitch + coff;
                *(u32x4*)(dp) = r0; *(u32x4*)(dp + 8) = r1;
            }
            ccur[0] = cnxt[0]; ccur[1] = cnxt[1];
        }
    }
};

__device__ __forceinline__ void phase_inproj(const Params& p, int l, unsigned char* smem) {
    const int kind = l % 3;
    InSched S; S.h = (const char*)p.h; S.wt = (const char*)sel4(p.wt_in, l); S.nK = kind == 0 ? 1 : 4; S.NU = 8 + 2 * S.nK; S.vrow = true;
    LAS float* ropeL = (LAS float*)((LAS unsigned char*)smem + 131072 + 18432);
    LAS float* gL = ropeL + 2048;
    {
        int tid = threadIdx.x; asm volatile("" : "+v"(tid));
        *(LAS f32x4*)(ropeL + tid * 4) = *(const f32x4*)(p.rope + tid * 4);
        if (tid < 64) gL[tid] = sel4(p.q_g, l)[tid]; else if (tid < 128) gL[tid] = sel4(p.k_g, l)[tid - 64];
        __syncthreads();
    }
    EpiIn E; E.ropeL = ropeL; E.gL = gL; E.q = p.q; E.k = p.k; E.vt = p.vt; E.sz = p.sz; E.nK = S.nK; E.do_rope = kind != 1; E.stg0 = (LAS unsigned char*)smem + 131072;
    pg8::gemm_phase(( LAS unsigned char*)smem, 1024, S, E);
}

struct OutSched {
    const char* og; const char* wt; int MT; bool ctxonly;
    __device__ __forceinline__ bool next(int i, pg8::Unit& u) const {
        int mt, un;
        if (ctxonly) { if (i > 0 || (blockIdx.x >> 3) >= 4) return false; mt = MLAT / 256 + (blockIdx.x & 7); un = blockIdx.x >> 3; }
        else if (!xcd_unit(i, MT, 4, mt, un)) return false;
        u.pm = mt; u.pn = un; u.kind = 0;
        u.a = og + (size_t)mt * 256 * D * 2; u.b = wt + (size_t)un * 256 * D * 2;
        return true;
    }
};
struct EpiOut {
    const float *x, *ctx, *mod; float *out, *xb; int l;
    __device__ __forceinline__ void operator()(const f32x4 (&acc)[2][2][4][2], const pg8::Unit& u, int wr, int wc, int fr, int fq) const {
        const int row0 = u.pm * 256;
        const bool isctx = row0 >= MLAT;
        const int bv = isctx ? 8 : (row0 >> 12);
        const int n0 = u.pn * 256 + wc * 32 + 4 * fq;
        const float* gtp = mod + ((size_t)l * 9 + bv) * 3072 + 2048 + n0;
        f32x4 g4[2][2];
#pragma unroll
        for (int bj = 0; bj < 2; ++bj)
#pragma unroll
            for (int n = 0; n < 2; ++n) g4[bj][n] = *(const f32x4*)(gtp + bj * 128 + n * 16);
        const float* src = l == 0 ? (isctx ? ctx + (size_t)(row0 - MLAT) * D : x + (size_t)row0 * D) : (isctx ? xb + (size_t)(row0 - MLAT) * D : out + (size_t)row0 * D);
        float* dstp = isctx ? xb + (size_t)(row0 - MLAT) * D : out + (size_t)row0 * D;
#pragma unroll
        for (int ai = 0; ai < 2; ++ai)
#pragma unroll
            for (int m = 0; m < 4; ++m) {
                const size_t ro = (size_t)(ai * 128 + wr * 64 + m * 16 + fr) * D + n0;
                f32x4 xv[2][2];
#pragma unroll
                for (int bj = 0; bj < 2; ++bj)
#pragma unroll
                    for (int n = 0; n < 2; ++n) xv[bj][n] = *(const f32x4*)(src + ro + bj * 128 + n * 16);
#pragma unroll
                for (int bj = 0; bj < 2; ++bj)
#pragma unroll
                    for (int n = 0; n < 2; ++n) *(f32x4*)(dstp + ro + bj * 128 + n * 16) = xv[bj][n] + g4[bj][n] * acc[ai][bj][m][n];
            }
    }
};

__device__ __forceinline__ void phase_outproj(const Params& p, int l, bool ctxonly, unsigned char* smem) {
    OutSched S; S.og = (const char*)p.og; S.wt = (const char*)sel4(p.wt_out, l); S.MT = MLAT / 256; S.ctxonly = ctxonly;
    EpiOut E; E.x = p.x; E.ctx = p.ctx; E.mod = p.mod; E.out = p.out; E.xb = p.xb; E.l = l;
    pg8::gemm_phase((LAS unsigned char*)smem, 1024, S, E);
}

namespace attn_a {
typedef unsigned short bf16;
using s16x4=__attribute__((ext_vector_type(4)))short;
constexpr int PQ=64;
constexpr int NW=8,QBLK=32,QB=QBLK*NW,KVBLK=64;
__device__ __forceinline__ int crow(int r,int hi){return (r&3)+8*(r>>2)+4*hi;}
#define SBAR() __builtin_amdgcn_sched_barrier(0)
__device__ __forceinline__ void cmask(f32x16&p0,f32x16&p1,int jb,int qrel,int hi){
  const float NEG=-INFINITY; int kb=64*jb+4*hi;
  #pragma unroll
  for(int r=0;r<16;++r){int kv=kb+(r&3)+8*(r>>2); if(kv>qrel)p0[r]=NEG; if(kv+32>qrel)p1[r]=NEG;}
}

constexpr int NSLOT=3, SLOTB=8192;
constexpr int LDS_K=0, LDS_V=NSLOT*SLOTB, LDS_WS=2*NSLOT*SLOTB, LDS_OST=LDS_WS+NW*64*4, LDS_BYTES=LDS_OST+NW*4096;
constexpr float C2=0.125f*1.4426950408889634f;
__device__ __forceinline__ void glds16(const void*gsrc,unsigned lds_dst){unsigned keep;
  asm volatile("s_mov_b32 %0, m0\n\ts_mov_b32 m0, %2\n\ts_nop 0\n\tglobal_load_lds_dwordx4 %1, off\n\ts_mov_b32 m0, %0":"=&s"(keep):"v"(gsrc),"s"(lds_dst):"memory");}
__device__ __forceinline__ float max3f(float a,float b,float c){float r;asm("v_max3_f32 %0, %1, %2, %3":"=v"(r):"v"(a),"v"(b),"v"(c));return r;}
__device__ __forceinline__ float max2f(float a,float b){float r;asm("v_max_f32_e32 %0, %1, %2":"=v"(r):"v"(a),"v"(b));return r;}
__device__ __forceinline__ float fadd_s(float a,float b){float r;asm("v_add_f32_e32 %0, %1, %2":"=v"(r):"v"(a),"v"(b));return r;}
__device__ __forceinline__ float fsub_s(float a,float b){float r;asm("v_sub_f32_e32 %0, %1, %2":"=v"(r):"v"(a),"v"(b));return r;}
typedef float f32x2_t __attribute__((ext_vector_type(2))); typedef __bf16 bf16x2_t __attribute__((ext_vector_type(2)));
__device__ __forceinline__ unsigned cvtpk_s(float lo,float hi){f32x2_t v={lo,hi};bf16x2_t b=__builtin_convertvector(v,bf16x2_t);return __builtin_bit_cast(unsigned,b);}
#define WAIT_BAR(N) asm volatile("s_waitcnt vmcnt(" #N ") lgkmcnt(0)\n\ts_barrier":::"memory")

__device__ __forceinline__ void qkt(f32x16&p0,f32x16&p1,const char*Kslot,const bf16x8*qr,const f32x16&negm,int r32,int hi){
  const char*kb=Kslot+hi*1024+r32*16;
  #pragma unroll
  for(int d0=0;d0<4;++d0){
    const bf16x8 b0=*reinterpret_cast<const bf16x8*>(kb+d0*2048);
    const bf16x8 b1=*reinterpret_cast<const bf16x8*>(kb+d0*2048+512);
    if(d0==0){p0=__builtin_amdgcn_mfma_f32_32x32x16_bf16(b0,qr[0],negm,0,0,0);p1=__builtin_amdgcn_mfma_f32_32x32x16_bf16(b1,qr[0],negm,0,0,0);}
    else{p0=__builtin_amdgcn_mfma_f32_32x32x16_bf16(b0,qr[d0],p0,0,0,0);p1=__builtin_amdgcn_mfma_f32_32x32x16_bf16(b1,qr[d0],p1,0,0,0);}}
}
typedef __attribute__((address_space(3))) const char* lds_cptr;
typedef short v4i16_t __attribute__((ext_vector_type(4)));
__device__ __forceinline__ void kload8(bf16x8*kf,lds_cptr kp){
  kf[0]=*(const __attribute__((address_space(3))) bf16x8*)(kp);      kf[1]=*(const __attribute__((address_space(3))) bf16x8*)(kp+512);
  kf[2]=*(const __attribute__((address_space(3))) bf16x8*)(kp+2048); kf[3]=*(const __attribute__((address_space(3))) bf16x8*)(kp+2560);
  kf[4]=*(const __attribute__((address_space(3))) bf16x8*)(kp+4096); kf[5]=*(const __attribute__((address_space(3))) bf16x8*)(kp+4608);
  kf[6]=*(const __attribute__((address_space(3))) bf16x8*)(kp+6144); kf[7]=*(const __attribute__((address_space(3))) bf16x8*)(kp+6656);
}
__device__ __forceinline__ void kload2(bf16x8*kf,lds_cptr kp,int j){ kf[2*j]=*(const __attribute__((address_space(3))) bf16x8*)(kp+j*2048); kf[2*j+1]=*(const __attribute__((address_space(3))) bf16x8*)(kp+j*2048+512); }
__device__ __forceinline__ s16x4 vtr(lds_cptr p){ return __builtin_bit_cast(s16x4,__builtin_amdgcn_ds_read_tr16_b64_v4i16((__attribute__((address_space(3))) v4i16_t*)p)); }
__device__ __forceinline__ float rowmax(const f32x16&p0,const f32x16&p1){
  float a=max3f(p0[0],p0[1],p1[0]),b=max3f(p0[2],p0[3],p1[1]);a=max3f(a,p1[2],p1[3]);
  #pragma unroll
  for(int r=4;r<16;r+=4){a=max3f(a,p0[r],p0[r+1]);b=max3f(b,p0[r+2],p0[r+3]);a=max3f(a,p1[r],p1[r+1]);b=max3f(b,p1[r+2],p1[r+3]);}
  const float m=max2f(a,b);
  auto rr=__builtin_amdgcn_permlane32_swap(__float_as_uint(m),__float_as_uint(m),false,false);
  return max2f(__uint_as_float(rr[0]),__uint_as_float(rr[1]));
}
__device__ __forceinline__ void pv(f32x16*o,int vb,bf16x8 pa0,bf16x8 pa1,bf16x8 pa2,bf16x8 pa3){
  #pragma unroll
  for(int d0=0;d0<2;++d0){s16x4 lo[4],hi[4];
    #pragma unroll
    for(int ks=0;ks<4;++ks){
      asm volatile("ds_read_b64_tr_b16 %0,%1 offset:%c2":"=&v"(lo[ks]):"v"(vb),"i"(d0*4096+ks*1024):"memory");
      asm volatile("ds_read_b64_tr_b16 %0,%1 offset:%c2":"=&v"(hi[ks]):"v"(vb),"i"(d0*4096+ks*1024+512):"memory");}
    asm volatile("s_waitcnt lgkmcnt(0)":::"memory");SBAR();
    #define PK(k) (bf16x8){lo[k][0],lo[k][1],lo[k][2],lo[k][3],hi[k][0],hi[k][1],hi[k][2],hi[k][3]}
    o[d0]=__builtin_amdgcn_mfma_f32_32x32x16_bf16(pa0,PK(0),o[d0],0,0,0);
    o[d0]=__builtin_amdgcn_mfma_f32_32x32x16_bf16(pa1,PK(1),o[d0],0,0,0);
    o[d0]=__builtin_amdgcn_mfma_f32_32x32x16_bf16(pa2,PK(2),o[d0],0,0,0);
    o[d0]=__builtin_amdgcn_mfma_f32_32x32x16_bf16(pa3,PK(3),o[d0],0,0,0);
    #undef PK
  }
}

template<int THRL,bool NBRM=false,bool DV2=false> __device__ __forceinline__ void attn_unit(const bf16*Qu,const bf16*__restrict__ Kh,const bf16*__restrict__ Vh,const int NT,const bf16*SZu,bf16*OGu,char*shm,
                                                                      const int rowoff=0,const int qrow0=0,const LAS float*rpbL=nullptr,const bf16*__restrict__ V2h=nullptr,float*Oraw=nullptr){
  constexpr int LDS_V2=LDS_BYTES, ND=DV2?4:2;
  #define WB(a,b) do{ if constexpr(DV2){WAIT_BAR(b);} else {WAIT_BAR(a);} }while(0)
  int tid=threadIdx.x; asm volatile("":"+v"(tid)); const int lane=tid&63,r32=lane&31,hi=lane>>5; const int wid=__builtin_amdgcn_readfirstlane(tid>>6);
  const bf16*Qw=Qu+(long)wid*QBLK*PQ;
  const unsigned lds0=(unsigned)(uintptr_t)shm;
  float*wsf=(float*)(shm+LDS_WS)+wid*64;
  const bf16*ksrc=Kh+(long)lane*PQ+wid*8;
  const bf16*vsrc=Vh+(long)(16*(wid&3)+(lane>>2))*PQ+(wid>>2)*32+(lane&3)*8;
  const unsigned kdst=lds0+LDS_K+wid*1024, vdst=lds0+LDS_V+wid*1024;
  #define TMAP(t) ((NBRM&&(t)>=4)?((t)+rowoff):(t))
  #define DMA_K(t,slot) glds16(ksrc+(long)TMAP(t)*KVBLK*PQ,(unsigned)__builtin_amdgcn_readfirstlane(kdst+(slot)))
  #define DMA_V(t,slot) glds16(vsrc+(long)TMAP(t)*KVBLK*PQ,(unsigned)__builtin_amdgcn_readfirstlane(vdst+(slot)))
  const bf16*v2src=DV2?V2h+(vsrc-Vh):vsrc; const unsigned v2dst=lds0+LDS_V2+wid*1024;
  #define DMA_V2(t,slot) do{ if constexpr(DV2) glds16(v2src+(long)TMAP(t)*KVBLK*PQ,(unsigned)__builtin_amdgcn_readfirstlane(v2dst+(slot))); }while(0)
  const int vb0=(int)(lds0+LDS_V)+((lane>>4)&1)*32+(lane&3)*8+(4*hi+((lane&15)>>2))*64;
  const char*Kbase=shm+LDS_K; bf16x8 kf[8];
  const lds_cptr shm3=(lds_cptr)shm; const lds_cptr kp0=shm3+LDS_K+hi*1024+r32*16; const lds_cptr vp0=shm3+LDS_V+((lane>>4)&1)*32+(lane&3)*8+(4*hi+((lane&15)>>2))*64;
  DMA_K(0,0);DMA_V(0,0);DMA_V2(0,0);DMA_K(1,SLOTB);
  bf16x8 qr[4];
  #pragma unroll
  for(int d0=0;d0<4;++d0)qr[d0]=*reinterpret_cast<const bf16x8*>(&Qw[(long)r32*PQ+d0*16+hi*8]);
  float mhat=0.f,l_reg=0.f;f32x16 o[ND];
  #pragma unroll
  for(int d_=0;d_<ND;++d_)o[d_]=f32x16{};
  f32x16 negm=f32x16{}; if constexpr(!DV2) asm volatile("":"+v"(negm));
  const f32x16 zero16=f32x16{};
  #define NEGM (DV2?zero16:negm)
  const int nq_r=qrow0+(wid>>1), nq_c=(wid&1)*32+r32, n_rsw=min(max(nq_r-4,0),56), n_cs=min(max(nq_c-8,0),48);
  #define CMASK(P0,P1,t) do{ if constexpr(NBRM){ const int t_=(t); if(t_>=4){ const int kr_=rowoff+t_-4; \
      if((unsigned)(kr_-n_rsw)>=8u){ _Pragma("unroll") for(int r=0;r<16;++r){P0[r]=-INFINITY;P1[r]=-INFINITY;} } \
      else{ const LAS float*bp_=rpbL+(kr_-nq_r+7)*31+15-nq_c; \
        _Pragma("unroll") for(int r=0;r<16;++r){ const int kc_=crow(r,hi); \
          const bool v0_=(unsigned)(kc_-n_cs)<16u, v1_=(unsigned)(kc_+32-n_cs)<16u; \
          const float b0_=v0_?bp_[kc_]:0.f, b1_=v1_?bp_[kc_+32]:0.f; \
          P0[r]=v0_?P0[r]+b0_:-INFINITY; P1[r]=v1_?P1[r]+b1_:-INFINITY; } } } } }while(0)
  bool resc=false;
  #define START(P0,P1) do{ const float rm=rowmax(P0,P1); resc=false; \
    { const float dl=rm; mhat=fadd_s(mhat,dl); \
      _Pragma("unroll") for(int r=0;r<16;++r){P0[r]=fsub_s(P0[r],dl);P1[r]=fsub_s(P1[r],dl);} \
      if constexpr(!DV2){ _Pragma("unroll") for(int r=0;r<16;++r)negm[r]=-mhat; asm volatile("":"+v"(negm)); } } \
    _Pragma("unroll") for(int r=0;r<16;++r)P0[r]=__builtin_amdgcn_exp2f(P0[r]); }while(0)
  #define RESC() do{ if(resc){ asm volatile("s_waitcnt lgkmcnt(0)":::"memory"); \
      _Pragma("unroll") for(int d_=0;d_<ND;++d_) _Pragma("unroll") for(int r=0;r<16;++r)o[d_][r]*=wsf[crow(r,hi)]; } }while(0)
  f32x16 pA0,pA1,pB0,pB1;
  int sl_prev=0,sl_cur=0,sl_next=SLOTB;
  #define ROT() do{sl_prev=sl_cur;sl_cur=sl_next;sl_next=(sl_next==(NSLOT-1)*SLOTB)?0:sl_next+SLOTB;}while(0)
  DMA_K(2,2*SLOTB);
  WB(3,4);
  qkt(pA0,pA1,Kbase,qr,NEGM,r32,hi);asm volatile("s_nop 15\n\ts_nop 7":"+v"(pA0),"+v"(pA1));CMASK(pA0,pA1,0);
  START(pA0,pA1);
  _Pragma("unroll") for(int r=0;r<16;++r)pA1[r]=__builtin_amdgcn_exp2f(pA1[r]);
  WAIT_BAR(0);
  DMA_K(3,0);DMA_V(1,SLOTB);DMA_V2(1,SLOTB);
  ROT();
  kload8(kf,kp0+sl_cur);
  WB(2,3);
  s16x4 vlo[8],vhi[8]; u32x4 pw0,pw1,pw2,pw3;
  #define PKW(P,B) cvtpk_s(P[B],P[B+1])
  #define PAF(k) __builtin_bit_cast(bf16x8,pw##k)
  #define VFR(i) (bf16x8){vlo[i][0],vlo[i][1],vlo[i][2],vlo[i][3],vhi[i][0],vhi[i][1],vhi[i][2],vhi[i][3]}
  #define PIN(x) asm volatile("":"+v"(x))
  #define MX3(a,b,c) __builtin_fmaxf(__builtin_fmaxf((a),(b)),(c))
  #define GAPA(MF,A0,A1,A2,A3,W0,W1,PW) do{ MF; sacc+=A0; sacc+=A1; sacc+=A2; sacc+=A3; PIN(sacc); W0; W1; PIN(PW); SBAR(); }while(0)
  #define EX(v) (DV2?__builtin_amdgcn_exp2f((v)-mhat):__builtin_amdgcn_exp2f(v))
  #define GAPB(MF,X,B) do{ MF; X[B]=EX(X[B]); X[B+1]=EX(X[B+1]); X[B+2]=EX(X[B+2]); X[B+3]=EX(X[B+3]); PIN(X); SBAR(); }while(0)
  #define GAPH(MF,X,B) do{ MF; X[B]=EX(X[B]); X[B+1]=EX(X[B+1]); PIN(X); SBAR(); }while(0)
  #define GAPX(MF,XA,BA,XH,BH) do{ if constexpr(DV2){ GAPH(MF,XH,BH); } else { GAPB(MF,XA,BA); } }while(0)
  #define VRD(i) do{ vlo[i]=vtr(vp_+(((i)>>2)*4096+((i)&3)*1024)); vhi[i]=vtr(vp_+(((i)>>2)*4096+((i)&3)*1024+512)); }while(0)
  #define KRD(G,j) do{ if(G){ kload2(kf,kp0+sl_next,j); SBAR(); } }while(0)
  #define KRD1(G,j) do{ if constexpr(!DV2){ KRD(G,j); } }while(0)
  #define V2R(i) do{ if constexpr(DV2){ vlo[i]=vtr(vq_+(((i)>>2)*4096+((i)&3)*1024)); vhi[i]=vtr(vq_+(((i)>>2)*4096+((i)&3)*1024+512)); SBAR(); } }while(0)
  #define STEP(C0,C1,P0,P1,t,GK,GV,GL) do{ SBAR(); \
    const lds_cptr vp_=vp0+sl_prev; const lds_cptr vq_=vp0+(LDS_V2-LDS_V)+sl_prev; (void)vq_; \
    VRD(0); SBAR(); float sacc=(P0[0]+P0[1]); \
    GAPA(C0=__builtin_amdgcn_mfma_f32_32x32x16_bf16(kf[0],qr[0],NEGM,0,0,0), P0[2],P0[3],P0[4],P0[5],     pw0[0]=PKW(P0,0), pw0[1]=PKW(P0,2), pw0); \
    VRD(4); SBAR(); GAPA(C1=__builtin_amdgcn_mfma_f32_32x32x16_bf16(kf[1],qr[0],NEGM,0,0,0), P0[6],P0[7],P0[8],P0[9],     pw0[2]=PKW(P0,4), pw0[3]=PKW(P0,6), pw0); \
    VRD(1); SBAR(); GAPA(C0=__builtin_amdgcn_mfma_f32_32x32x16_bf16(kf[2],qr[1],C0,0,0,0),   P0[10],P0[11],P0[12],P0[13], pw1[0]=PKW(P0,8), pw1[1]=PKW(P0,10), pw1); \
    VRD(5); SBAR(); GAPA(C1=__builtin_amdgcn_mfma_f32_32x32x16_bf16(kf[3],qr[1],C1,0,0,0),   P0[14],P0[15],P1[0],P1[1],   pw1[2]=PKW(P0,12),pw1[3]=PKW(P0,14), pw1); \
    VRD(2); SBAR(); GAPA(C0=__builtin_amdgcn_mfma_f32_32x32x16_bf16(kf[4],qr[2],C0,0,0,0),   P1[2],P1[3],P1[4],P1[5],     pw2[0]=PKW(P1,0), pw2[1]=PKW(P1,2), pw2); \
    VRD(6); SBAR(); GAPA(C1=__builtin_amdgcn_mfma_f32_32x32x16_bf16(kf[5],qr[2],C1,0,0,0),   P1[6],P1[7],P1[8],P1[9],     pw2[2]=PKW(P1,4), pw2[3]=PKW(P1,6), pw2); \
    VRD(3); SBAR(); GAPA(C0=__builtin_amdgcn_mfma_f32_32x32x16_bf16(kf[6],qr[3],C0,0,0,0),   P1[10],P1[11],P1[12],P1[13], pw3[0]=PKW(P1,8), pw3[1]=PKW(P1,10), pw3); \
    VRD(7); SBAR(); GAPA(C1=__builtin_amdgcn_mfma_f32_32x32x16_bf16(kf[7],qr[3],C1,0,0,0),   P1[14],P1[15],0.f,0.f,       pw3[2]=PKW(P1,12),pw3[3]=PKW(P1,14), pw3); \
    l_reg+=sacc; \
    if(GK){DMA_K((t)+3,sl_cur);} if(GV){DMA_V((t)+1,sl_next);DMA_V2((t)+1,sl_next);} \
    CMASK(C0,C1,t); \
    { float a=MX3(C0[0],C0[1],C1[0]),b=MX3(C0[2],C0[3],C1[1]); a=MX3(a,C1[2],C1[3]); \
      _Pragma("unroll") for(int r=4;r<16;r+=4){a=MX3(a,C0[r],C0[r+1]);b=MX3(b,C0[r+2],C0[r+3]);a=MX3(a,C1[r],C1[r+1]);b=MX3(b,C1[r+2],C1[r+3]);} \
      float rm=__builtin_fmaxf(a,b); { auto rr=__builtin_amdgcn_permlane32_swap(__float_as_uint(rm),__float_as_uint(rm),false,false); rm=__builtin_fmaxf(__uint_as_float(rr[0]),__uint_as_float(rr[1])); } \
      if constexpr(DV2) rm-=mhat; \
      resc=false; \
      if(__builtin_expect(__any(rm>(float)THRL),0)){ const float dl=__builtin_fmaxf(rm,0.f); mhat+=dl; \
        if constexpr(!DV2){ _Pragma("unroll") for(int r=0;r<16;++r){C0[r]-=dl;C1[r]-=dl;} } \
        if constexpr(!DV2){ _Pragma("unroll") for(int r=0;r<16;++r)negm[r]=-mhat; asm volatile("":"+v"(negm)); } \
        const float f=__builtin_amdgcn_exp2f(-dl); l_reg*=f; if(hi==0)wsf[r32]=f; resc=true; } } \
    SBAR(); \
    GAPX(o[0]=__builtin_amdgcn_mfma_f32_32x32x16_bf16(PAF(0),VFR(0),o[0],0,0,0), C0,0,  C0,0); V2R(0); \
    GAPX(o[1]=__builtin_amdgcn_mfma_f32_32x32x16_bf16(PAF(0),VFR(4),o[1],0,0,0), C0,4,  C0,2); V2R(4); \
    KRD1(GL,0); GAPX(o[0]=__builtin_amdgcn_mfma_f32_32x32x16_bf16(PAF(1),VFR(1),o[0],0,0,0), C0,8,  C0,4); V2R(1); \
    KRD1(GL,1); GAPX(o[1]=__builtin_amdgcn_mfma_f32_32x32x16_bf16(PAF(1),VFR(5),o[1],0,0,0), C0,12, C0,6); V2R(5); \
    KRD1(GL,2); GAPX(o[0]=__builtin_amdgcn_mfma_f32_32x32x16_bf16(PAF(2),VFR(2),o[0],0,0,0), C1,0,  C0,8); V2R(2); \
    KRD1(GL,3); GAPX(o[1]=__builtin_amdgcn_mfma_f32_32x32x16_bf16(PAF(2),VFR(6),o[1],0,0,0), C1,4,  C0,10); V2R(6); \
    GAPX(o[0]=__builtin_amdgcn_mfma_f32_32x32x16_bf16(PAF(3),VFR(3),o[0],0,0,0), C1,8,  C0,12); V2R(3); \
    GAPX(o[1]=__builtin_amdgcn_mfma_f32_32x32x16_bf16(PAF(3),VFR(7),o[1],0,0,0), C1,12, C0,14); V2R(7); \
    if constexpr(DV2){ \
      GAPH(o[ND-2]=__builtin_amdgcn_mfma_f32_32x32x16_bf16(PAF(0),VFR(0),o[ND-2],0,0,0), C1,0); \
      GAPH(o[ND-1]=__builtin_amdgcn_mfma_f32_32x32x16_bf16(PAF(0),VFR(4),o[ND-1],0,0,0), C1,2); \
      KRD(GL,0); GAPH(o[ND-2]=__builtin_amdgcn_mfma_f32_32x32x16_bf16(PAF(1),VFR(1),o[ND-2],0,0,0), C1,4); \
      KRD(GL,1); GAPH(o[ND-1]=__builtin_amdgcn_mfma_f32_32x32x16_bf16(PAF(1),VFR(5),o[ND-1],0,0,0), C1,6); \
      KRD(GL,2); GAPH(o[ND-2]=__builtin_amdgcn_mfma_f32_32x32x16_bf16(PAF(2),VFR(2),o[ND-2],0,0,0), C1,8); \
      KRD(GL,3); GAPH(o[ND-1]=__builtin_amdgcn_mfma_f32_32x32x16_bf16(PAF(2),VFR(6),o[ND-1],0,0,0), C1,10); \
      GAPH(o[ND-2]=__builtin_amdgcn_mfma_f32_32x32x16_bf16(PAF(3),VFR(3),o[ND-2],0,0,0), C1,12); \
      GAPH(o[ND-1]=__builtin_amdgcn_mfma_f32_32x32x16_bf16(PAF(3),VFR(7),o[ND-1],0,0,0), C1,14); } \
    }while(0)
  int t=1;
  for(;t+5<NT;t+=2){
    STEP(pB0,pB1,pA0,pA1,t,true,true,true);     WB(2,3); RESC(); ROT();
    STEP(pA0,pA1,pB0,pB1,t+1,true,true,true);   WB(2,3); RESC(); ROT();
  }
  #define ENDW(tt) do{ if((tt)+3<NT){WB(2,3);} else if((tt)+2<NT){WB(1,2);} else {WAIT_BAR(0);} }while(0)
  for(;t+1<NT;t+=2){
    STEP(pB0,pB1,pA0,pA1,t,(t+3<NT),(t+1<NT),(t+1<NT));       ENDW(t);   RESC(); ROT();
    STEP(pA0,pA1,pB0,pB1,t+1,(t+4<NT),(t+2<NT),(t+2<NT));     ENDW(t+1); RESC(); ROT();
  }
  STEP(pB0,pB1,pA0,pA1,NT-1,false,false,false); RESC();
  { float sacc=pB0[0]+pB0[1]; _Pragma("unroll") for(int r=2;r<16;++r)sacc+=pB0[r]; _Pragma("unroll") for(int r=0;r<16;++r)sacc+=pB1[r]; l_reg+=sacc;
    pw0=(u32x4){PKW(pB0,0),PKW(pB0,2),PKW(pB0,4),PKW(pB0,6)};pw1=(u32x4){PKW(pB0,8),PKW(pB0,10),PKW(pB0,12),PKW(pB0,14)};pw2=(u32x4){PKW(pB1,0),PKW(pB1,2),PKW(pB1,4),PKW(pB1,6)};pw3=(u32x4){PKW(pB1,8),PKW(pB1,10),PKW(pB1,12),PKW(pB1,14)};
    SBAR(); pv(o,vb0+sl_cur,PAF(0),PAF(1),PAF(2),PAF(3)); if constexpr(DV2) pv(o+2,vb0+(LDS_V2-LDS_V)+sl_cur,PAF(0),PAF(1),PAF(2),PAF(3)); }
  #undef PKW
  #undef PAF
  #undef VFR
  #undef PIN
  #undef MX3
  #undef GAPA
  #undef GAPB
  #undef GAPH
  #undef GAPX
  #undef EX
  #undef VRD
  #undef KRD
  #undef KRD1
  #undef V2R
  #undef STEP
  #undef ENDW
  {auto rr=__builtin_amdgcn_permlane32_swap(__float_as_uint(l_reg),__float_as_uint(l_reg),false,false);l_reg=__uint_as_float(rr[0])+__uint_as_float(rr[1]);}
  if(hi==0)wsf[32+r32]=l_reg;asm volatile("s_waitcnt lgkmcnt(0)":::"memory");
  float rli[16];
  #pragma unroll
  for(int r=0;r<16;++r)rli[r]=__builtin_amdgcn_rcpf(wsf[32+crow(r,hi)]);
  if constexpr(DV2){ float*Orw=Oraw+(long)wid*QBLK*128;
    #pragma unroll
    for(int r=0;r<16;++r){const int orow=crow(r,hi);
      #pragma unroll
      for(int d0=0;d0<4;++d0) Orw[orow*128+d0*32+r32]=o[d0][r]*rli[r];}
  } else {
  bf16*Ow=OGu+(long)wid*QBLK*1024; const bf16*Zw=SZu+(long)wid*QBLK*1024;
  { bf16*stg=(bf16*)(shm+LDS_OST)+wid*2048;
    #pragma unroll
    for(int r=0;r<16;++r){const int orow=crow(r,hi);
      #pragma unroll
      for(int d0=0;d0<2;++d0) stg[orow*64+d0*32+r32]=(bf16)(pk_bf16(o[d0][r]*rli[r],0.f)&0xffffu);}
    asm volatile("s_waitcnt lgkmcnt(0)":::"memory");
    #pragma unroll
    for(int i=0;i<4;++i){const int row=i*8+(lane>>3),ch=lane&7; const u32x4 v=*(const u32x4*)(stg+row*64+ch*8); const u32x4 z=*(const u32x4*)(Zw+(long)row*1024+ch*8); u32x4 g;
      #pragma unroll
      for(int e=0;e<4;++e){ const float a0=__uint_as_float(v[e]<<16)*__uint_as_float(z[e]<<16), a1=__uint_as_float(v[e]&0xffff0000u)*__uint_as_float(z[e]&0xffff0000u); g[e]=pk_bf16(a0,a1); }
      *(u32x4*)(Ow+(long)row*1024+ch*8)=g;} }
  }
  asm volatile("s_waitcnt lgkmcnt(0)\n\ts_barrier":::"memory");
  #undef DMA_K
  #undef DMA_V2
  #undef NEGM
  #undef WB
  #undef TMAP
  #undef DMA_V
  #undef CMASK
  #undef START
  #undef RESC
  #undef ROT
}
#undef SBAR
#undef WAIT_BAR
}

constexpr int ATT_BUF = 64 * LDT + 128 * LDT;
template <int NDB, bool NBR>
__device__ __forceinline__ void attn_pass(const int tid, const bf16_t* __restrict__ Qrow, const bf16_t* __restrict__ Kb, const bf16_t* __restrict__ Vb,
                                          int ntiles, int rs0, int qr, int qc, int rsw, const float* srpb,
                                          bf16_t* sbase, f32x16 (&O)[NDB], float& lsum_out) {
    const int lane = tid & 63, lr = lane & 31, lh = lane >> 5;
    const int lrow = tid >> 3, lpart = tid & 7;
    constexpr int NV = NDB / 2;
    bf16x8 qf[4];
#pragma unroll
    for (int s = 0; s < 4; ++s) qf[s] = *(const bf16x8*)(Qrow + s * 16);
#pragma unroll
    for (int db = 0; db < NDB; ++db)
#pragma unroll
        for (int i = 0; i < 16; ++i) O[db][i] = 0.f;
    float m = -1e30f, lsum = 0.f;
    u32x4 kreg, vreg[NV];
    auto key0_of = [&](int it) -> int { return (NBR && it >= 4) ? (CTXL + (rs0 + it - 4) * 64) : it * 64; };
    auto gload = [&](int it) {
        const int key0 = key0_of(it);
        kreg = *(const u32x4*)(Kb + (size_t)(key0 + lrow) * 64 + lpart * 8);
#pragma unroll
        for (int j = 0; j < NV; ++j) vreg[j] = *(const u32x4*)(Vb + (size_t)(lrow + 64 * j) * TT + key0 + lpart * 8);
    };
    auto swrite = [&](int buf) {
        bf16_t* sb = sbase + buf * ATT_BUF;
        *(u32x4*)(sb + lrow * LDT + lpart * 8) = kreg;
#pragma unroll
        for (int j = 0; j < NV; ++j) *(u32x4*)(sb + 64 * LDT + (lrow + 64 * j) * LDT + lpart * 8) = vreg[j];
    };
    gload(0);
    __syncthreads();
    swrite(0);
    if (ntiles > 1) gload(1);
    __syncthreads();
    const int kfo = swap23(lr) * LDT + lh * 8;
    const int vfo = 64 * LDT + lr * LDT + lh * 8;
    const int cs_ = min(max(qc - 8, 0), 48);
#pragma unroll 1
    for (int it = 0; it < ntiles; ++it) {
        if (it + 1 < ntiles) swrite((it + 1) & 1);
        if (it + 2 < ntiles) gload(it + 2);
        const bf16_t* sb = sbase + (it & 1) * ATT_BUF;
        const int kr = rs0 + it - 4;
        const bool act = !NBR || it < 4 || (kr >= rsw && kr < rsw + 8);
        if (act) {
            f32x16 S[2];
#pragma unroll
            for (int sub = 0; sub < 2; ++sub) {
#pragma unroll
                for (int i = 0; i < 16; ++i) S[sub][i] = 0.f;
#pragma unroll
                for (int s = 0; s < 4; ++s) {
                    const bf16x8 kf = *(const bf16x8*)(sb + kfo + sub * 32 * LDT + s * 16);
                    S[sub] = MFMA32(kf, qf[s], S[sub]);
                }
            }
            if (NBR && it >= 4) {
                const float* bp = srpb + (kr - qr + 7) * 31 + 15 - qc;
#pragma unroll
                for (int sub = 0; sub < 2; ++sub)
#pragma unroll
                    for (int i = 0; i < 16; ++i) {
                        const int kc = sub * 32 + (i & 7) + 8 * lh + 16 * (i >> 3);
                        const bool valid = (unsigned)(kc - cs_) < 16u;
                        const float bias = valid ? bp[kc] : 0.f;
                        S[sub][i] = valid ? S[sub][i] + bias : -1e30f;
                    }
            }
            float mx = S[0][0];
#pragma unroll
            for (int i = 1; i < 16; ++i) mx = fmaxf(mx, S[0][i]);
#pragma unroll
            for (int i = 0; i < 16; ++i) mx = fmaxf(mx, S[1][i]);
            mx = fmaxf(mx, __shfl_xor(mx, 32));
            const bool need = mx > m;
            {
                const float mnew = need ? mx : m;
                const float alpha = fast_exp2(m - mnew);
                m = mnew;
                lsum *= alpha;
#pragma unroll
                for (int db = 0; db < NDB; ++db)
#pragma unroll
                    for (int i = 0; i < 16; ++i) O[db][i] *= alpha;
            }
            float rs = 0.f;
#pragma unroll
            for (int sub = 0; sub < 2; ++sub)
#pragma unroll
                for (int i = 0; i < 16; ++i) { const float pv = fast_exp2(S[sub][i] - m); S[sub][i] = pv; rs += pv; }
            lsum += rs;
#pragma unroll
            for (int sub = 0; sub < 2; ++sub)
#pragma unroll
                for (int s2 = 0; s2 < 2; ++s2) {
                    u32x4 pw;
                    pw.x = pk_bf16(S[sub][8 * s2 + 0], S[sub][8 * s2 + 1]); pw.y = pk_bf16(S[sub][8 * s2 + 2], S[sub][8 * s2 + 3]);
                    pw.z = pk_bf16(S[sub][8 * s2 + 4], S[sub][8 * s2 + 5]); pw.w = pk_bf16(S[sub][8 * s2 + 6], S[sub][8 * s2 + 7]);
                    const bf16x8 pf = __builtin_bit_cast(bf16x8, pw);
#pragma unroll
                    for (int db = 0; db < NDB; ++db) {
                        const bf16x8 vf = *(const bf16x8*)(sb + vfo + db * 32 * LDT + (sub * 2 + s2) * 16);
                        O[db] = MFMA32(vf, pf, O[db]);
                    }
                }
        }
        __syncthreads();
    }
    lsum_out = lsum + __shfl_xor(lsum, 32);
}

template <int NDB>
__device__ __forceinline__ void attn_store(const Params& p, int row, int col0, const f32x16 (&O)[NDB], int lh) {
    const bf16_t* szr = p.sz + (size_t)row * D + col0;
    bf16_t* ogr = p.og + (size_t)row * D + col0;
#pragma unroll
    for (int db = 0; db < NDB; ++db)
#pragma unroll
        for (int g4 = 0; g4 < 4; ++g4) {
            const int d0 = db * 32 + 8 * g4 + 4 * lh;
            const u32x2 zz = *(const u32x2*)(szr + d0);
            const float z0 = __uint_as_float(zz.x << 16), z1 = __uint_as_float(zz.x & 0xffff0000u);
            const float z2 = __uint_as_float(zz.y << 16), z3 = __uint_as_float(zz.y & 0xffff0000u);
            u32x2 o; o.x = pk_bf16(O[db][4 * g4 + 0] * z0, O[db][4 * g4 + 1] * z1); o.y = pk_bf16(O[db][4 * g4 + 2] * z2, O[db][4 * g4 + 3] * z3);
            *(u32x2*)(ogr + d0) = o;
        }
}

__device__ __forceinline__ void phase_attn(const Params& p, int l, unsigned char* smem) {
    const int kind = l % 3;
    const bool need_ctx = l < 3;
    bf16_t* sbase = (bf16_t*)smem; float* srpb = (float*)(sbase + 2 * ATT_BUF);
    int tid = threadIdx.x; asm volatile("" : "+v"(tid));
    const int lane = tid & 63, w = tid >> 6, lr = lane & 31, lh = lane >> 5;
    const int b = blockIdx.x & 7, xj = blockIdx.x >> 3, xn = gridDim.x >> 3;
    if (kind == 0) {
        const int nlat = 16 * 16, nctx = need_ctx ? 16 : 0;
        for (int li = xj; li < nlat + nctx; li += xn) {
            int head, qb; const bool isctx = li >= nlat;
            if (!isctx) { qb = li & 15; head = li >> 4; } else { qb = 0; head = li - nlat; }
            const int kh = head >> 2;
            const bf16_t* Qu = p.q + (((size_t)b * 16 + head) * TT + (isctx ? 0 : CTXL + qb * 256)) * 64;
            const bf16_t* Kh = p.k + ((size_t)b * 4 + kh) * TT * 64;
            const bf16_t* Vh = p.vt + ((size_t)b * 4 + kh) * TT * 64;
            const size_t grow0 = isctx ? (size_t)MLAT + b * CTXL : (size_t)b * SEQ + qb * 256;
            attn_a::attn_unit<8>(Qu, Kh, Vh, isctx ? 4 : TT / 64, p.sz + grow0 * D + head * 64, p.og + grow0 * D + head * 64, (char*)smem);
        }
    } else if (kind == 1) {
        const int nlat = 16 * 16, nctx = need_ctx ? 16 : 0;
        LAS float* rpbL = (LAS float*)((LAS unsigned char*)smem + 90112);
        for (int li = xj; li < nlat + nctx; li += xn) {
            int head, qb; const bool isctx = li >= nlat;
            if (!isctx) { qb = li & 15; head = li >> 4; } else { qb = 0; head = li - nlat; }
            const bf16_t* Qu = p.q + (((size_t)b * 16 + head) * TT + (isctx ? 0 : CTXL + qb * 256)) * 64;
            const bf16_t* Kh = p.k + ((size_t)b * 16 + head) * TT * 64;
            const bf16_t* Vh = p.vt + ((size_t)b * 16 + head) * TT * 64;
            const size_t grow0 = isctx ? (size_t)MLAT + b * CTXL : (size_t)b * SEQ + qb * 256;
            if (!isctx) {
                const int rstart = min(min(max(4 * qb - 4, 0), 56), 52);
                for (int idx = tid; idx < 465; idx += NTHR) rpbL[idx] = p.rpb[head * 465 + idx] * LOG2E;
                attn_a::attn_unit<8, true>(Qu, Kh, Vh, 16, p.sz + grow0 * D + head * 64, p.og + grow0 * D + head * 64, (char*)smem, rstart, 4 * qb, rpbL);
            } else {
                attn_a::attn_unit<8, false>(Qu, Kh, Vh, 4, p.sz + grow0 * D + head * 64, p.og + grow0 * D + head * 64, (char*)smem);
            }
        }
    } else {
        const float lam = p.lam[0];
        const float post = 1.0f - p.lam_init;
        float* blk = p.scr + (size_t)blockIdx.x * (2 * 256 * 128);
        const int nlat = 8 * 16, nctx = need_ctx ? 8 : 0;
        for (int li = xj; li < nlat + nctx; li += xn) {
            int hh, qb; const bool isctx = li >= nlat;
            if (!isctx) { qb = li & 15; hh = li >> 4; } else { qb = 0; hh = li - nlat; }
            const int qpos0 = isctx ? 0 : CTXL + qb * 256;
            const size_t grow0 = isctx ? (size_t)MLAT + b * CTXL : (size_t)b * SEQ + qb * 256;
            const int nt = isctx ? 4 : TT / 64;
            const bf16_t* Va = p.vt + ((size_t)b * 16 + hh * 2) * TT * 64;
            const bf16_t* Vb = p.vt + ((size_t)b * 16 + hh * 2 + 1) * TT * 64;
#pragma unroll 1
            for (int mm = 0; mm < 2; ++mm) {
                const bf16_t* Qu = p.q + (((size_t)b * 16 + hh * 2 + mm) * TT + qpos0) * 64;
                const bf16_t* Kh = p.k + ((size_t)b * 16 + hh * 2 + mm) * TT * 64;
                attn_a::attn_unit<8, false, true>(Qu, Kh, Va, nt, nullptr, nullptr, (char*)smem, 0, 0, nullptr, Vb, blk + mm * (256 * 128));
            }
            __syncthreads();
            const float g0 = p.subln_g[lane * 2], g1 = p.subln_g[lane * 2 + 1];
#pragma unroll 8
            for (int i = 0; i < 32; ++i) {
                const int qrow = w * 32 + i;
                const float2 a0 = *(const float2*)(blk + (size_t)qrow * 128 + lane * 2);
                const float2 a1 = *(const float2*)(blk + (size_t)(256 + qrow) * 128 + lane * 2);
                const unsigned zz = *(const unsigned*)(p.sz + (grow0 + qrow) * D + hh * 128 + lane * 2);
                const float o0 = a0.x - lam * a1.x, o1 = a0.y - lam * a1.y;
                float ss = o0 * o0 + o1 * o1;
                ss = wave_sum64(ss);
                const float rstd = rsqrtf(ss * (1.0f / 128.0f) + EPS) * post;
                const float z0 = __uint_as_float(zz << 16), z1 = __uint_as_float(zz & 0xffff0000u);
                *(unsigned*)(p.og + (grow0 + qrow) * D + hh * 128 + lane * 2) = pk_bf16(o0 * rstd * g0 * z0, o1 * rstd * g1 * z1);
            }
            __syncthreads();
        }
    }
}

__device__ __forceinline__ void grid_barrier(unsigned* ctr, unsigned target) {
    asm volatile("s_waitcnt vmcnt(0)" ::: "memory");
    __syncthreads();
    if (threadIdx.x == 0) {
        __builtin_amdgcn_fence(__ATOMIC_RELEASE, "agent");
        asm volatile("s_waitcnt vmcnt(0)" ::: "memory");
        __hip_atomic_fetch_add(ctr, 1u, __ATOMIC_RELAXED, __HIP_MEMORY_SCOPE_AGENT);
        while (__hip_atomic_load(ctr, __ATOMIC_RELAXED, __HIP_MEMORY_SCOPE_AGENT) < target) __builtin_amdgcn_s_sleep(1);
        __builtin_amdgcn_fence(__ATOMIC_ACQUIRE, "agent");
        asm volatile("s_waitcnt vmcnt(0)" ::: "memory");
    }
    __syncthreads();
}

__device__ __forceinline__ void group_barrier(unsigned* bar, unsigned target) {
    grid_barrier(bar + 64 * (1 + (blockIdx.x & 7)), target);
}

__global__ void __launch_bounds__(NTHR, 2) fwd_kernel(Params p) {
    extern __shared__ __attribute__((aligned(16))) unsigned char smem[];
    cg::grid_group grid = cg::this_grid();
    if (blockIdx.x == 0 && threadIdx.x < 9) p.bar[64 * threadIdx.x] = 0u;
    phase0(p, smem);
    grid.sync();
    unsigned tgt = 0;
    const unsigned nb = gridDim.x >> 3;
    phase_prep(p, 0, 0);
    tgt += nb; group_barrier(p.bar, tgt);
#pragma unroll 1
    for (int l = 0; l < 4; ++l) {
        phase_inproj(p, l, smem);
        tgt += nb; group_barrier(p.bar, tgt);
        phase_attn(p, l, smem);
        tgt += nb; group_barrier(p.bar, tgt);
        const int nst = l < 3 ? 3 : 1;
#pragma unroll 1
        for (int st = 0; st < nst; ++st) {
            const bool do_out = st == 0 || (st == 1 && (blockIdx.x >> 3) < 4);
            if (do_out) phase_outproj(p, l, st == 1, smem);
            else phase_prep(p, l + 1, st);
            if (l < 3) { tgt += nb; group_barrier(p.bar, tgt); }
        }
    }
}

extern "C" void kernel_launch(void* const* d_in, const int* in_sizes, int n_in, void* d_out, int out_size, void* d_ws, size_t ws_size,
                              hipStream_t stream) {
    static int grid_blocks = 0;
    if (!grid_blocks) {
        int dev = 0, cus = 0;
        (void)hipGetDevice(&dev);
        (void)hipDeviceGetAttribute(&cus, hipDeviceAttributeMultiprocessorCount, dev);
        if (hipFuncSetAttribute((const void*)fwd_kernel, hipFuncAttributeMaxDynamicSharedMemorySize, LDS_BYTES) != hipSuccess)
            fprintf(stderr, "hipFuncSetAttribute(max dynamic LDS) failed\n");
        (void)hipGetLastError();
        grid_blocks = cus > 0 ? (cus & ~7) : 256;
    }
    Params p{};
    p.x = (const float*)d_in[0]; p.c = (const float*)d_in[1]; p.ctx = (const float*)d_in[2]; p.c_ctx = (const float*)d_in[3];
    p.norm_g = (const float*)d_in[4]; p.ada_w = (const float*)d_in[5]; p.ada_b = (const float*)d_in[6];
    const float* a_w_in = (const float*)d_in[7]; const float* a_q_g = (const float*)d_in[8]; const float* a_k_g = (const float*)d_in[9];
    const float* a_w_out = (const float*)d_in[10];
    const float* b_w_in = (const float*)d_in[11]; const float* b_q_g = (const float*)d_in[12]; const float* b_k_g = (const float*)d_in[13];
    const float* b_w_out = (const float*)d_in[15];
    const float* c_w_in = (const float*)d_in[16]; const float* c_q_g = (const float*)d_in[17]; const float* c_k_g = (const float*)d_in[18];
    const float* c_w_out = (const float*)d_in[24];
    p.w_in[0] = a_w_in; p.w_in[1] = b_w_in; p.w_in[2] = c_w_in; p.w_in[3] = a_w_in + (size_t)1024 * 2560;
    p.w_out[0] = a_w_out; p.w_out[1] = b_w_out; p.w_out[2] = c_w_out; p.w_out[3] = a_w_out + (size_t)1024 * 1024;
    p.q_g[0] = a_q_g; p.q_g[1] = b_q_g; p.q_g[2] = c_q_g; p.q_g[3] = a_q_g + 64;
    p.k_g[0] = a_k_g; p.k_g[1] = b_k_g; p.k_g[2] = c_k_g; p.k_g[3] = a_k_g + 64;
    p.rpb = (const float*)d_in[14];
    p.lq1 = (const float*)d_in[19]; p.lk1 = (const float*)d_in[20]; p.lq2 = (const float*)d_in[21]; p.lk2 = (const float*)d_in[22];
    p.subln_g = (const float*)d_in[23];
    p.out = (float*)d_out;
    char* ws = (char*)d_ws; size_t off = 0;
    auto take = [&](size_t bytes) { char* r = ws + off; off += (bytes + 255) & ~(size_t)255; return r; };
    p.xb = (float*)take((size_t)MCTX * D * 4);
    p.h = (bf16_t*)take((size_t)MTOT * D * 2);
    p.q = (bf16_t*)take((size_t)NB * 16 * TT * 64 * 2);
    p.k = (bf16_t*)take((size_t)NB * 16 * TT * 64 * 2);
    p.vt = (bf16_t*)take((size_t)NB * 1024 * TT * 2);
    p.sz = (bf16_t*)take((size_t)MTOT * D * 2);
    p.og = p.h;
    for (int l = 0; l < 4; ++l) { const int N = (l == 0 || l == 3) ? 2560 : 4096; p.wt_in[l] = (bf16_t*)take((size_t)N * 1024 * 2); }
    for (int l = 0; l < 4; ++l) p.wt_out[l] = (bf16_t*)take((size_t)1024 * 1024 * 2);
    p.mod = (float*)take((size_t)4 * 9 * 3072 * 4);
    p.rope = (float*)take(64 * 16 * 2 * 4);
    p.lam = (float*)take(256);
    p.bar = (unsigned*)take(4096);
    p.scr = (float*)take((size_t)256 * 2 * 256 * 128 * 4);
    if (off > ws_size) { fprintf(stderr, "workspace too small: need %zu have %zu\n", off, ws_size); return; }
    p.lam_init = (float)(0.8 - 0.6 * std::exp(-0.3 * 2.0));
    p.pad0 = 0.f;
    void* args[] = {&p};
    hipError_t e = hipLaunchCooperativeKernel((void*)fwd_kernel, dim3(grid_blocks), dim3(NTHR), args, LDS_BYTES, stream);
    if (e != hipSuccess) fprintf(stderr, "cooperative launch failed: %s (grid %d)\n", hipGetErrorString(e), grid_blocks);
}
```

```cpp
#include <hip/hip_runtime.h>
#include <hip/hip_cooperative_groups.h>
#include <cstdio>
#include <cmath>
namespace cg = cooperative_groups;

typedef unsigned short bf16_t;
constexpr float LOG2E_ = 1.4426950408889634f;
typedef short bf16x8 __attribute__((ext_vector_type(8)));
typedef float f32x16 __attribute__((ext_vector_type(16)));
typedef float f32x4 __attribute__((ext_vector_type(4)));
typedef unsigned u32x4 __attribute__((ext_vector_type(4)));
typedef unsigned u32x2 __attribute__((ext_vector_type(2)));
#define LAS __attribute__((address_space(3)))

#define MFMA32(a, b, c) __builtin_amdgcn_mfma_f32_32x32x16_bf16((a), (b), (c), 0, 0, 0)

constexpr int D = 1024, NB = 8, SEQ = 4096, CTXL = 256, TT = SEQ + CTXL;
constexpr int MLAT = NB * SEQ, MCTX = NB * CTXL, MTOT = MLAT + MCTX;
constexpr int LDT = 72;
constexpr int NTHR = 512;
constexpr int LDS_BYTES = 158208;
constexpr float LOG2E = 1.4426950408889634f;
constexpr float QSCALE = 0.125f * LOG2E;
constexpr float EPS = 1e-6f;

__constant__ float INVF[16] = {1.0f, 0.5623413324356079f, 0.3162277638912201f, 0.17782793939113617f, 0.10000000149011612f,
    0.05623413249850273f, 0.03162277489900589f, 0.017782794311642647f, 0.009999999776482582f, 0.005623413249850273f,
    0.003162277629598975f, 0.0017782794311642647f, 0.0010000000474974513f, 0.000562341301701963f, 0.0003162277571391314f,
    0.00017782794020604342f};

struct Params {
    const float *x, *c, *ctx, *c_ctx, *norm_g, *ada_w, *ada_b;
    const float* w_in[4]; const float* w_out[4]; const float* q_g[4]; const float* k_g[4];
    const float *rpb, *lq1, *lk1, *lq2, *lk2, *subln_g;
    float* out;
    float* xb;
    bf16_t *h, *q, *k, *vt, *sz, *og;
    bf16_t* wt_in[4]; bf16_t* wt_out[4];
    float *mod, *rope, *lam, *scr;
    unsigned* bar;
    float lam_init; float pad0;
};

__device__ __forceinline__ unsigned pk_bf16(float lo, float hi) {
    unsigned r; asm("v_cvt_pk_bf16_f32 %0, %1, %2" : "=v"(r) : "v"(lo), "v"(hi)); return r;
}
__device__ __forceinline__ int swap23(int x) { return (x & 0x13) | ((x & 4) << 1) | ((x & 8) >> 1); }
__device__ __forceinline__ float fast_exp2(float x) { return __builtin_amdgcn_exp2f(x); }
__device__ __forceinline__ float wave_sum64(float v) {
    v += __uint_as_float(__builtin_amdgcn_mov_dpp(__float_as_uint(v), 0xB1, 0xF, 0xF, true));
    v += __uint_as_float(__builtin_amdgcn_mov_dpp(__float_as_uint(v), 0x4E, 0xF, 0xF, true));
    v += __uint_as_float(__builtin_amdgcn_mov_dpp(__float_as_uint(v), 0x141, 0xF, 0xF, true));
    v += __uint_as_float(__builtin_amdgcn_mov_dpp(__float_as_uint(v), 0x140, 0xF, 0xF, true));
    { auto rr = __builtin_amdgcn_permlane16_swap(__float_as_uint(v), __float_as_uint(v), false, false); v = __uint_as_float(rr[0]) + __uint_as_float(rr[1]); }
    { auto rr = __builtin_amdgcn_permlane32_swap(__float_as_uint(v), __float_as_uint(v), false, false); v = __uint_as_float(rr[0]) + __uint_as_float(rr[1]); }
    return v;
}
__device__ __forceinline__ float silu_f(float z) { return z * __builtin_amdgcn_rcpf(1.0f + __builtin_amdgcn_exp2f(-LOG2E_ * z)); }
template <typename T> __device__ __forceinline__ T sel4(T const (&a)[4], int l) { return l == 0 ? a[0] : (l == 1 ? a[1] : (l == 2 ? a[2] : a[3])); }
__host__ __device__ __forceinline__ int layer_N(int l) { return (l == 0 || l == 3) ? 2560 : 4096; }

namespace pg8 {
constexpr int BM = 256, BK = 64, HALF = 128, HTB = HALF * BK * 2, STAGE_BYTES = 8 * HTB;
__device__ __forceinline__ int lds_byte(int r, int c) { const int st = (r >> 4) * 2 + (c >> 5), rr = r & 15, cc = c & 31, ob = rr * 64 + cc * 2; return st * 1024 + (ob ^ (((ob >> 9) & 1) << 5)); }
__device__ __forceinline__ void stage_rc(int b, int& R, int& C) { const int st = b / 1024, sb = b % 1024, swz = sb ^ (((sb >> 9) & 1) << 5); R = (st >> 1) * 16 + swz / 64; C = (st & 1) * 32 + (swz % 64) / 2; }

struct Unit { const char* a; const char* b; int pm, pn, kind; };

template <class Epi, class Sched>
__device__ __forceinline__ void gemm_phase(LAS unsigned char* lds, const int K, const Sched& S, const Epi& E) {
    int tid = threadIdx.x; asm volatile("" : "+v"(tid));
    const int wid = __builtin_amdgcn_readfirstlane(tid >> 6), lane = tid & 63, wr = wid >> 2, wc = wid & 3, fr = lane & 15, fq = lane >> 4;
    const int nt = K / BK;
    unsigned voffA[2];
#pragma unroll
    for (int i = 0; i < 2; ++i) { int R, C; stage_rc(tid * 16 + i * 8192, R, C); voffA[i] = (unsigned)(R * K + C) * 2u; }
    const size_t kstep = (size_t)(BK * 2);
    const size_t hstep = (size_t)HALF * K * 2;
    const unsigned ldsw = (unsigned)wid * 1024u;
    const int aoff = lds_byte(wr * 64 + fr, fq * 8), boff = lds_byte(wc * 32 + fr, fq * 8);
#define PG8_SA(b, h) (((b) * 2 + (h)) * HTB)
#define PG8_SB(b, h) ((4 + (b) * 2 + (h)) * HTB)
#define PG8_STAGE(bufoff, gbase, voff) do { _Pragma("unroll") for (int _i = 0; _i < 2; ++_i) \
        __builtin_amdgcn_global_load_lds((const unsigned*)((const char*)(gbase) + (voff)[_i]), (LAS unsigned*)(lds + (bufoff) + ldsw + _i * 8192), 16, 0, 0); } while (0)
#define PG8_LDA(dst, b, h) do { _Pragma("unroll") for (int m = 0; m < 4; ++m) _Pragma("unroll") for (int k = 0; k < 2; ++k) dst[m][k] = *(const LAS bf16x8*)(lds + PG8_SA(b, h) + aoff + m * 2048 + k * 1024); } while (0)
#define PG8_LDB(dst, b, h) do { _Pragma("unroll") for (int n = 0; n < 2; ++n) _Pragma("unroll") for (int k = 0; k < 2; ++k) dst[n][k] = *(const LAS bf16x8*)(lds + PG8_SB(b, h) + boff + n * 2048 + k * 1024); } while (0)
#define PG8_MMA(ai, bj, At, Bt) do { __builtin_amdgcn_s_setprio(1); _Pragma("unroll") for (int m = 0; m < 4; ++m) _Pragma("unroll") for (int n = 0; n < 2; ++n) _Pragma("unroll") for (int k = 0; k < 2; ++k) \
        acc[ai][bj][m][n] = __builtin_amdgcn_mfma_f32_16x16x32_bf16(Bt[n][k], At[m][k], acc[ai][bj][m][n], 0, 0, 0); __builtin_amdgcn_s_setprio(0); } while (0)
#define PG8_WAIT_V(n) asm volatile("s_waitcnt vmcnt(" #n ")" ::: "memory")
#define PG8_WAIT_L(n) asm volatile("s_waitcnt lgkmcnt(" #n ")" ::: "memory")
#define PG8_BAR __builtin_amdgcn_s_barrier()
#define PG8_SCHED __builtin_amdgcn_sched_barrier(0)
    Unit cur, nxt; int ui = 0;
    if (!S.next(0, cur)) return;
    f32x4 acc[2][2][4][2];
#pragma unroll
    for (int a = 0; a < 2; ++a)
#pragma unroll
        for (int b = 0; b < 2; ++b)
#pragma unroll
            for (int m = 0; m < 4; ++m)
#pragma unroll
                for (int n = 0; n < 2; ++n) acc[a][b][m][n] = (f32x4){0.f, 0.f, 0.f, 0.f};
    bf16x8 At[4][2], B0[2][2], B1[2][2];
    const char* cA = cur.a; const char* cB = cur.b;
    {
        PG8_STAGE(PG8_SB(0, 0), cB, voffA); PG8_STAGE(PG8_SB(0, 1), cB + hstep, voffA); PG8_STAGE(PG8_SA(0, 0), cA, voffA); PG8_STAGE(PG8_SA(0, 1), cA + hstep, voffA);
        if (wr == 1) PG8_BAR;
        PG8_WAIT_V(2); PG8_BAR;
        PG8_STAGE(PG8_SB(1, 0), cB + kstep, voffA); PG8_STAGE(PG8_SA(1, 0), cA + kstep, voffA); PG8_STAGE(PG8_SB(1, 1), cB + hstep + kstep, voffA);
        PG8_WAIT_V(6); PG8_BAR;
    }
    for (;;) {
        const bool has_next = S.next(ui + 1, nxt);
        const char* nA = has_next ? nxt.a : cA; const char* nB = has_next ? nxt.b : cB;
        for (int t = 0; t < nt; t += 2) {
            const bool last = (t == nt - 2);
            const char* a1 = cA + (size_t)(t + 1) * kstep;
            const char* a2 = last ? nA : cA + (size_t)(t + 2) * kstep; const char* b2 = last ? nB : cB + (size_t)(t + 2) * kstep;
            const char* a3 = a2 + kstep; const char* b3 = b2 + kstep;
            PG8_LDB(B0, 0, 0); PG8_LDB(B1, 0, 1); PG8_SCHED; PG8_LDA(At, 0, 0); PG8_STAGE(PG8_SA(1, 1), a1 + hstep, voffA);
            PG8_WAIT_V(8); PG8_WAIT_L(0); PG8_BAR; PG8_MMA(0, 0, At, B0); PG8_MMA(0, 1, At, B1); PG8_BAR; PG8_SCHED;
            PG8_LDA(At, 0, 1); PG8_STAGE(PG8_SB(0, 0), b2, voffA); PG8_STAGE(PG8_SB(0, 1), b2 + hstep, voffA); PG8_STAGE(PG8_SA(0, 0), a2, voffA);
            PG8_WAIT_V(8); PG8_WAIT_L(0); PG8_BAR; PG8_MMA(1, 0, At, B0); PG8_MMA(1, 1, At, B1); PG8_BAR; PG8_SCHED;
            PG8_LDB(B0, 1, 0); PG8_LDB(B1, 1, 1); PG8_SCHED; PG8_LDA(At, 1, 0); PG8_STAGE(PG8_SA(0, 1), a2 + hstep, voffA);
            PG8_WAIT_V(8); PG8_WAIT_L(0); PG8_BAR; PG8_MMA(0, 0, At, B0); PG8_MMA(0, 1, At, B1); PG8_BAR; PG8_SCHED;
            PG8_LDA(At, 1, 1); PG8_STAGE(PG8_SB(1, 0), b3, voffA); PG8_STAGE(PG8_SB(1, 1), b3 + hstep, voffA); PG8_STAGE(PG8_SA(1, 0), a3, voffA);
            PG8_WAIT_V(8); PG8_WAIT_L(0); PG8_BAR; PG8_MMA(1, 0, At, B0); PG8_MMA(1, 1, At, B1); PG8_BAR; PG8_SCHED;
        }
        if (wr == 0) PG8_BAR;
        E(acc, cur, wr, wc, fr, fq);
        if (!has_next) break;
#pragma unroll
        for (int a = 0; a < 2; ++a)
#pragma unroll
            for (int b = 0; b < 2; ++b)
#pragma unroll
                for (int m = 0; m < 4; ++m)
#pragma unroll
                    for (int n = 0; n < 2; ++n) acc[a][b][m][n] = (f32x4){0.f, 0.f, 0.f, 0.f};
        cur = nxt; cA = nA; cB = nB; ++ui;
        if (wr == 1) PG8_BAR;
    }
    PG8_WAIT_V(0);
    PG8_BAR;
#undef PG8_SA
#undef PG8_SB
#undef PG8_STAGE
#undef PG8_LDA
#undef PG8_LDB
#undef PG8_MMA
#undef PG8_WAIT_V
#undef PG8_WAIT_L
#undef PG8_BAR
#undef PG8_SCHED
}
}

__device__ __forceinline__ bool xcd_unit(int i, int MT, int NU, int& mt, int& un) {
    int bx = blockIdx.x, gx = gridDim.x;
    asm volatile("" : "+s"(NU), "+s"(MT), "+s"(bx), "+s"(gx));
    const int xcd = bx & 7, j = bx >> 3, nbx = gx >> 3;
    const int mcount = MT >> 3;
    const int q = j + i * nbx;
    if (q >= mcount * NU) return false;
    const int g = q / (8 * NU), r = q - g * 8 * NU;
    const int gsz = min(8, mcount - g * 8);
    const int ml = g * 8 + r % gsz; un = r / gsz;
    mt = ml < 16 ? 16 * xcd + ml : MLAT / 256 + xcd;
    return true;
}

__device__ __forceinline__ void phase0(const Params& p, unsigned char* smem) {
    int tid = threadIdx.x; asm volatile("" : "+v"(tid));
    constexpr int N_ADA = 192, N_WT = 4352;
    for (int item = blockIdx.x; item < N_ADA + N_WT + 1; item += gridDim.x) {
        if (item < N_ADA) {
            float* ssc = (float*)smem;
            float* red = ssc + 9 * 1024;
            const int l = item / 48, n0 = (item % 48) * 64;
            __syncthreads();
            for (int idx = tid; idx < 9 * 1024; idx += NTHR) {
                const int v = idx >> 10, kk = idx & 1023;
                const float cv = v < 8 ? p.c[v * 1024 + kk] : p.c_ctx[kk];
                ssc[idx] = cv / (1.0f + expf(-cv));
            }
            __syncthreads();
            const int kg = tid >> 6, col = tid & 63;
            float acc[9];
#pragma unroll
            for (int v = 0; v < 9; ++v) acc[v] = 0.f;
            const float* wp = p.ada_w + ((size_t)l * 1024 + kg * 128) * 3072 + n0 + col;
#pragma unroll 2
            for (int kk = 0; kk < 128; kk += 4) {
                const float w0 = wp[(size_t)(kk + 0) * 3072], w1 = wp[(size_t)(kk + 1) * 3072], w2 = wp[(size_t)(kk + 2) * 3072], w3 = wp[(size_t)(kk + 3) * 3072];
#pragma unroll
                for (int v = 0; v < 9; ++v) {
                    const float4 sv = *(const float4*)(ssc + v * 1024 + kg * 128 + kk);
                    acc[v] += sv.x * w0 + sv.y * w1 + sv.z * w2 + sv.w * w3;
                }
            }
#pragma unroll
            for (int v = 0; v < 9; ++v) red[(kg * 9 + v) * 64 + col] = acc[v];
            __syncthreads();
            for (int idx = tid; idx < 9 * 64; idx += NTHR) {
                const int v = idx >> 6, cc = idx & 63;
                float s = 0.f;
#pragma unroll
                for (int g = 0; g < 8; ++g) s += red[(g * 9 + v) * 64 + cc];
                s += p.ada_b[l * 3072 + n0 + cc];
                p.mod[((size_t)l * 9 + v) * 3072 + n0 + cc] = s;
            }
        } else if (item < N_ADA + N_WT) {
            int t = item - N_ADA;
            const float* W; bf16_t* Wt; int N; int nperm = 0;
            int l = 0; bool found = false;
#pragma unroll
            for (int m = 0; m < 4; ++m) {
                const int ntl = 16 * (layer_N(m) / 64);
                if (!found) { if (t < ntl) { l = m; found = true; } else t -= ntl; }
            }
            if (found) { W = sel4(p.w_in, l); Wt = sel4(p.wt_in, l); N = layer_N(l); nperm = 1024 + ((l == 0 || l == 3) ? 256 : 1024); }
            else { l = t / 256; t = t % 256; W = sel4(p.w_out, l); Wt = sel4(p.wt_out, l); N = 1024; }
            const int k0 = (t & 15) * 64, n0 = (t >> 4) * 64;
            float* sT = (float*)smem;
            float4 v[2];
#pragma unroll
            for (int i = 0; i < 2; ++i) {
                const int kk = (tid >> 4) + 32 * i, n4 = (tid & 15) * 4;
                v[i] = *(const float4*)(W + (size_t)(k0 + kk) * N + n0 + n4);
            }
            __syncthreads();
#pragma unroll
            for (int i = 0; i < 2; ++i) {
                const int kk = (tid >> 4) + 32 * i, n4 = (tid & 15) * 4;
                sT[(n4 + 0) * 65 + kk] = v[i].x; sT[(n4 + 1) * 65 + kk] = v[i].y;
                sT[(n4 + 2) * 65 + kk] = v[i].z; sT[(n4 + 3) * 65 + kk] = v[i].w;
            }
            __syncthreads();
            {
                const int n = tid >> 3, k8 = (tid & 7) * 8;
                const float* s = sT + n * 65 + k8;
                u32x4 o; o.x = pk_bf16(s[0], s[1]); o.y = pk_bf16(s[2], s[3]); o.z = pk_bf16(s[4], s[5]); o.w = pk_bf16(s[6], s[7]);
                int f = n0 + n;
                if (f < nperm) { const int fl = f & 255, hh = fl >> 6, d = fl & 63; f = (f & ~255) + 128 * (d >> 5) + 32 * hh + (d & 31); }
                *(u32x4*)(Wt + (size_t)f * 1024 + k0 + k8) = o;
            }
        } else {
            for (int idx = tid; idx < 1024; idx += NTHR) {
                const int pos = idx >> 4, f = idx & 15;
                const float angf = (float)pos * INVF[f];
                const double a = (double)angf;
                const double kq = rint(a * 0.63661977236758134308);
                const double r = a - kq * 1.57079632679489661923;
                const double r2 = r * r;
                double sn = r * (1.0 + r2 * (-1.0 / 6 + r2 * (1.0 / 120 + r2 * (-1.0 / 5040 + r2 * (1.0 / 362880 + r2 * (-1.0 / 39916800 + r2 * (1.0 / 6227020800.0)))))));
                double cs = 1.0 + r2 * (-0.5 + r2 * (1.0 / 24 + r2 * (-1.0 / 720 + r2 * (1.0 / 40320 + r2 * (-1.0 / 3628800 + r2 * (1.0 / 479001600.0))))));
                const int qd = ((int)kq) & 3;
                double so, co;
                if (qd == 0) { so = sn; co = cs; } else if (qd == 1) { so = cs; co = -sn; } else if (qd == 2) { so = -sn; co = -cs; } else { so = -cs; co = sn; }
                p.rope[idx * 2 + 0] = (float)co; p.rope[idx * 2 + 1] = (float)so;
            }
            if (tid == 0) {
                float d1 = 0.f, d2 = 0.f;
                for (int i = 0; i < 64; ++i) { d1 += p.lq1[i] * p.lk1[i]; d2 += p.lq2[i] * p.lk2[i]; }
                p.lam[0] = expf(d1) - expf(d2) + p.lam_init;
            }
        }
    }
}

__device__ __forceinline__ const float* xin_row(const Params& p, int l, int row) {
    if (l == 0) return row < MLAT ? p.x + (size_t)row * D : p.ctx + (size_t)(row - MLAT) * D;
    return row < MLAT ? p.out + (size_t)row * D : p.xb + (size_t)(row - MLAT) * D;
}

__device__ __forceinline__ void phase_prep(const Params& p, int l, int mode) {
    asm volatile("" : "+s"(l), "+s"(mode));
    int tid = threadIdx.x; asm volatile("" : "+v"(tid));
    const int lane = tid & 63, w = tid >> 6;
    const float* g = p.norm_g + l * D;
    const int xb_ = blockIdx.x & 7, xj_ = (int)(blockIdx.x >> 3) - (mode == 1 ? 4 : 0), xn_ = (int)(gridDim.x >> 3) - (mode == 1 ? 4 : 0);
    const int lr_lo = mode == 2 ? SEQ : 0, lr_hi = mode == 1 ? SEQ : SEQ + CTXL;
    for (int lrow = lr_lo + xj_ * 8 + w; lrow < lr_hi; lrow += xn_ * 8) {
        const int row = lrow < SEQ ? xb_ * SEQ + lrow : MLAT + xb_ * CTXL + (lrow - SEQ);
        const float* xr = xin_row(p, l, row);
        const int bv = row < MLAT ? (row >> 12) : 8;
        const float* md = p.mod + ((size_t)l * 9 + bv) * 3072;
        float4 v[4]; float ss = 0.f;
#pragma unroll
        for (int j = 0; j < 4; ++j) {
            v[j] = *(const float4*)(xr + j * 256 + lane * 4);
            ss += v[j].x * v[j].x + v[j].y * v[j].y + v[j].z * v[j].z + v[j].w * v[j].w;
        }
#pragma unroll
        for (int o = 32; o >= 1; o >>= 1) ss += __shfl_xor(ss, o);
        const float rstd = rsqrtf(ss * (1.0f / 1024.0f) + EPS);
#pragma unroll
        for (int j = 0; j < 4; ++j) {
            const int col = j * 256 + lane * 4;
            const float4 gg = *(const float4*)(g + col);
            const float4 sh = *(const float4*)(md + col);
            const float4 sc = *(const float4*)(md + 1024 + col);
            const float a0 = v[j].x * rstd * gg.x * (1.0f + sc.x) + sh.x;
            const float a1 = v[j].y * rstd * gg.y * (1.0f + sc.y) + sh.y;
            const float a2 = v[j].z * rstd * gg.z * (1.0f + sc.z) + sh.z;
            const float a3 = v[j].w * rstd * gg.w * (1.0f + sc.w) + sh.w;
            u32x2 o; o.x = pk_bf16(a0, a1); o.y = pk_bf16(a2, a3);
            *(u32x2*)(p.h + (size_t)row * D + col) = o;
        }
    }
}

struct InSched {
    const char* h; const char* wt; int nK, NU; bool vrow;
    __device__ __forceinline__ bool next(int i, pg8::Unit& u) const {
        int mt, un;
        if (!xcd_unit(i, MTOT / 256, NU, mt, un)) return false;
        u.pm = mt; u.pn = un;
        const char* hp = h + (size_t)mt * 256 * D * 2;
        const char* wp = wt + (size_t)un * 256 * D * 2;
        const int kind = un < 4 ? 0 : (un < 4 + nK ? 1 : (un < 4 + 2 * nK ? 2 : 3));
        u.kind = (kind == 2 && vrow) ? 4 : kind;
        if (u.kind == 2) { u.a = wp; u.b = hp; } else { u.a = hp; u.b = wp; }
        return true;
    }
};

struct EpiIn {
    const LAS float* ropeL; const LAS float* gL; bf16_t *q, *k, *vt, *sz; int nK; bool do_rope; LAS unsigned char* stg0;
    __device__ __forceinline__ void operator()(const f32x4 (&acc)[2][2][4][2], const pg8::Unit& u, int wr, int wc, int fr, int fq) const {
        const int row0 = u.pm * 256;
        const bool isctx = row0 >= MLAT;
        int b, t0, pos0;
        if (!isctx) { b = row0 >> 12; t0 = row0 & 4095; pos0 = CTXL + t0; } else { b = (row0 - MLAT) >> 8; t0 = 0; pos0 = 0; }
        const int lane = fr + 16 * fq, wid = wr * 4 + wc;
        LAS unsigned char* stg = stg0 + wid * 2304;
        LAS unsigned char* wp = stg + fr * 144 + fq * 8;
        const int rr = lane >> 2, ch = lane & 3;
        const LAS unsigned char* rp = stg + rr * 144 + ch * 32;
        bf16_t* dbase; size_t rpitch; int coff;
        const int kind = u.kind;
        if (kind == 3) { dbase = sz + (size_t)row0 * D + (u.pn - 4 - 2 * nK) * 256 + wc * 32; rpitch = D; coff = (ch >> 1) * 128 + (ch & 1) * 16; }
        else if (kind == 4) { const int VH = nK * 4; const int vh = (u.pn - 4 - nK) * 4 + (wc >> 1) + 2 * (ch >> 1);
            dbase = vt + (((size_t)b * VH + vh) * TT + pos0) * 64 + (wc & 1) * 32; rpitch = 64; coff = (ch & 1) * 16; }
        else if (kind == 2) { const int VF = nK * 256;
            dbase = vt + ((size_t)b * VF + (u.pn - 4 - nK) * 256) * TT + pos0 + wc * 32; rpitch = TT; coff = (ch >> 1) * 128 + (ch & 1) * 16; }
        else { const bool isq = kind == 0; const int head = isq ? u.pn * 4 + wc : (u.pn - 4) * 4 + wc;
            dbase = (isq ? q + ((size_t)b * 16 + head) * TT * 64 : k + ((size_t)b * (nK * 4) + head) * TT * 64) + (size_t)pos0 * 64; rpitch = 64; coff = ch * 16; }
        const LAS float* gp = gL + (kind == 0 ? 0 : 64);
        const float osc = kind == 0 ? QSCALE : 1.0f;
        const bool rp_on = do_rope && !isctx;
        f32x4 g4[2][2], rc[2][2], ccur[2], cnxt[2];
        if (kind <= 1) {
#pragma unroll
            for (int bj = 0; bj < 2; ++bj)
#pragma unroll
                for (int n = 0; n < 2; ++n) g4[bj][n] = *(const LAS f32x4*)(gp + 32 * bj + 16 * n + 4 * fq);
#pragma unroll
            for (int ai = 0; ai < 2; ++ai) {
                const int pos = ((t0 >> 6) + 2 * ai + wr) & 63;
                rc[ai][0] = *(const LAS f32x4*)(ropeL + (pos * 16 + 4 * fq) * 2); rc[ai][1] = *(const LAS f32x4*)(ropeL + (pos * 16 + 4 * fq) * 2 + 4);
            }
            ccur[0] = *(const LAS f32x4*)(ropeL + (fr * 16 + 4 * fq) * 2); ccur[1] = *(const LAS f32x4*)(ropeL + (fr * 16 + 4 * fq) * 2 + 4);
        }
#pragma unroll
        for (int m = 0; m < 4; ++m) {
            if (kind <= 1 && m < 3) { const int pos = (m + 1) * 16 + fr; cnxt[0] = *(const LAS f32x4*)(ropeL + (pos * 16 + 4 * fq) * 2); cnxt[1] = *(const LAS f32x4*)(ropeL + (pos * 16 + 4 * fq) * 2 + 4); }
#pragma unroll
            for (int ai = 0; ai < 2; ++ai) {
                const int tl = ai * 128 + wr * 64 + m * 16;
                u32x2 o[2][2];
                if (kind == 3) {
#pragma unroll
                    for (int bj = 0; bj < 2; ++bj)
#pragma unroll
                        for (int n = 0; n < 2; ++n) { const f32x4 v = acc[ai][bj][m][n]; o[bj][n].x = pk_bf16(silu_f(v[0]), silu_f(v[1])); o[bj][n].y = pk_bf16(silu_f(v[2]), silu_f(v[3])); }
                } else if (kind >= 2) {
#pragma unroll
                    for (int bj = 0; bj < 2; ++bj)
#pragma unroll
                        for (int n = 0; n < 2; ++n) { const f32x4 v = acc[ai][bj][m][n]; o[bj][n].x = pk_bf16(v[0], v[1]); o[bj][n].y = pk_bf16(v[2], v[3]); }
                } else {
                    float ss = 0.f;
#pragma unroll
                    for (int bj = 0; bj < 2; ++bj)
#pragma unroll
                        for (int n = 0; n < 2; ++n) { const f32x4 v = acc[ai][bj][m][n]; ss += v[0] * v[0] + v[1] * v[1] + v[2] * v[2] + v[3] * v[3]; }
                    { auto r16 = __builtin_amdgcn_permlane16_swap(__float_as_uint(ss), __float_as_uint(ss), false, false); ss = __uint_as_float(r16[0]) + __uint_as_float(r16[1]);
                      auto r32 = __builtin_amdgcn_permlane32_swap(__float_as_uint(ss), __float_as_uint(ss), false, false); ss = __uint_as_float(r32[0]) + __uint_as_float(r32[1]); }
                    const float rstd = rsqrtf(ss * (1.0f / 64.0f) + EPS);
#pragma unroll
                    for (int bj = 0; bj < 2; ++bj) {
                        f32x4 x1 = acc[ai][bj][m][0] * rstd * g4[bj][0];
                        f32x4 x2 = acc[ai][bj][m][1] * rstd * g4[bj][1];
                        {
                            const f32x4 cs0 = bj == 0 ? rc[ai][0] : ccur[0], cs1 = bj == 0 ? rc[ai][1] : ccur[1];
                            f32x4 cc = (f32x4){cs0[0], cs0[2], cs1[0], cs1[2]}, sn = (f32x4){cs0[1], cs0[3], cs1[1], cs1[3]};
                            if (!rp_on) { cc = (f32x4){1.f, 1.f, 1.f, 1.f}; sn = (f32x4){0.f, 0.f, 0.f, 0.f}; }
                            const f32x4 y1 = x1 * cc - x2 * sn, y2 = x2 * cc + x1 * sn;
                            x1 = y1; x2 = y2;
                        }
                        x1 = x1 * osc; x2 = x2 * osc;
                        o[bj][0].x = pk_bf16(x1[0], x1[1]); o[bj][0].y = pk_bf16(x1[2], x1[3]); o[bj][1].x = pk_bf16(x2[0], x2[1]); o[bj][1].y = pk_bf16(x2[2], x2[3]);
                    }
                }
#pragma unroll
                for (int bj = 0; bj < 2; ++bj)
#pragma unroll
                    for (int n = 0; n < 2; ++n) *(LAS u32x2*)(wp + (32 * bj + 16 * n) * 2) = o[bj][n];
                const u32x4 r0 = *(const LAS u32x4*)(rp), r1 = *(const LAS u32x4*)(rp + 16);
                bf16_t* dp = dbase + (size_t)(tl + rr) * rpitch + coff;
                *(u32x4*)(dp) = r0; *(u32x4*)(dp + 8) = r1;
            }
            ccur[0] = cnxt[0]; ccur[1] = cnxt[1];
        }
    }
};

__device__ __forceinline__ void phase_inproj(const Params& p, int l, unsigned char* smem) {
    const int kind = l % 3;
    InSched S; S.h = (const char*)p.h; S.wt = (const char*)sel4(p.wt_in, l); S.nK = kind == 0 ? 1 : 4; S.NU = 8 + 2 * S.nK; S.vrow = true;
    LAS float* ropeL = (LAS float*)((LAS unsigned char*)smem + 131072 + 18432);
    LAS float* gL = ropeL + 2048;
    {
        int tid = threadIdx.x; asm volatile("" : "+v"(tid));
        *(LAS f32x4*)(ropeL + tid * 4) = *(const f32x4*)(p.rope + tid * 4);
        if (tid < 64) gL[tid] = sel4(p.q_g, l)[tid]; else if (tid < 128) gL[tid] = sel4(p.k_g, l)[tid - 64];
        __syncthreads();
    }
    EpiIn E; E.ropeL = ropeL; E.gL = gL; E.q = p.q; E.k = p.k; E.vt = p.vt; E.sz = p.sz; E.nK = S.nK; E.do_rope = kind != 1; E.stg0 = (LAS unsigned char*)smem + 131072;
    pg8::gemm_phase(( LAS unsigned char*)smem, 1024, S, E);
}

struct OutSched {
    const char* og; const char* wt; int MT; bool ctxonly;
    __device__ __forceinline__ bool next(int i, pg8::Unit& u) const {
        int mt, un;
        if (ctxonly) { if (i > 0 || (blockIdx.x >> 3) >= 4) return false; mt = MLAT / 256 + (blockIdx.x & 7); un = blockIdx.x >> 3; }
        else if (!xcd_unit(i, MT, 4, mt, un)) return false;
        u.pm = mt; u.pn = un; u.kind = 0;
        u.a = og + (size_t)mt * 256 * D * 2; u.b = wt + (size_t)un * 256 * D * 2;
        return true;
    }
};
struct EpiOut {
    const float *x, *ctx, *mod; float *out, *xb; int l;
    __device__ __forceinline__ void operator()(const f32x4 (&acc)[2][2][4][2], const pg8::Unit& u, int wr, int wc, int fr, int fq) const {
        const int row0 = u.pm * 256;
        const bool isctx = row0 >= MLAT;
        const int bv = isctx ? 8 : (row0 >> 12);
        const int n0 = u.pn * 256 + wc * 32 + 4 * fq;
        const float* gtp = mod + ((size_t)l * 9 + bv) * 3072 + 2048 + n0;
        f32x4 g4[2][2];
#pragma unroll
        for (int bj = 0; bj < 2; ++bj)
#pragma unroll
            for (int n = 0; n < 2; ++n) g4[bj][n] = *(const f32x4*)(gtp + bj * 128 + n * 16);
        const float* src = l == 0 ? (isctx ? ctx + (size_t)(row0 - MLAT) * D : x + (size_t)row0 * D) : (isctx ? xb + (size_t)(row0 - MLAT) * D : out + (size_t)row0 * D);
        float* dstp = isctx ? xb + (size_t)(row0 - MLAT) * D : out + (size_t)row0 * D;
#pragma unroll
        for (int ai = 0; ai < 2; ++ai)
#pragma unroll
            for (int m = 0; m < 4; ++m) {
                const size_t ro = (size_t)(ai * 128 + wr * 64 + m * 16 + fr) * D + n0;
                f32x4 xv[2][2];
#pragma unroll
                for (int bj = 0; bj < 2; ++bj)
#pragma unroll
                    for (int n = 0; n < 2; ++n) xv[bj][n] = *(const f32x4*)(src + ro + bj * 128 + n * 16);
#pragma unroll
                for (int bj = 0; bj < 2; ++bj)
#pragma unroll
                    for (int n = 0; n < 2; ++n) *(f32x4*)(dstp + ro + bj * 128 + n * 16) = xv[bj][n] + g4[bj][n] * acc[ai][bj][m][n];
            }
    }
};

__device__ __forceinline__ void phase_outproj(const Params& p, int l, bool ctxonly, unsigned char* smem) {
    OutSched S; S.og = (const char*)p.og; S.wt = (const char*)sel4(p.wt_out, l); S.MT = MLAT / 256; S.ctxonly = ctxonly;
    EpiOut E; E.x = p.x; E.ctx = p.ctx; E.mod = p.mod; E.out = p.out; E.xb = p.xb; E.l = l;
    pg8::gemm_phase((LAS unsigned char*)smem, 1024, S, E);
}

namespace attn_a {
typedef unsigned short bf16;
using s16x4=__attribute__((ext_vector_type(4)))short;
constexpr int PQ=64;
constexpr int NW=8,QBLK=32,QB=QBLK*NW,KVBLK=64;
__device__ __forceinline__ int crow(int r,int hi){return (r&3)+8*(r>>2)+4*hi;}
#define SBAR() __builtin_amdgcn_sched_barrier(0)
__device__ __forceinline__ void cmask(f32x16&p0,f32x16&p1,int jb,int qrel,int hi){
  const float NEG=-INFINITY; int kb=64*jb+4*hi;
  #pragma unroll
  for(int r=0;r<16;++r){int kv=kb+(r&3)+8*(r>>2); if(kv>qrel)p0[r]=NEG; if(kv+32>qrel)p1[r]=NEG;}
}

constexpr int NSLOT=3, SLOTB=8192;
constexpr int LDS_K=0, LDS_V=NSLOT*SLOTB, LDS_WS=2*NSLOT*SLOTB, LDS_OST=LDS_WS+NW*64*4, LDS_BYTES=LDS_OST+NW*4096;
constexpr float C2=0.125f*1.4426950408889634f;
__device__ __forceinline__ void glds16(const void*gsrc,unsigned lds_dst){unsigned keep;
  asm volatile("s_mov_b32 %0, m0\n\ts_mov_b32 m0, %2\n\ts_nop 0\n\tglobal_load_lds_dwordx4 %1, off\n\ts_mov_b32 m0, %0":"=&s"(keep):"v"(gsrc),"s"(lds_dst):"memory");}
__device__ __forceinline__ float max3f(float a,float b,float c){float r;asm("v_max3_f32 %0, %1, %2, %3":"=v"(r):"v"(a),"v"(b),"v"(c));return r;}
__device__ __forceinline__ float max2f(float a,float b){float r;asm("v_max_f32_e32 %0, %1, %2":"=v"(r):"v"(a),"v"(b));return r;}
__device__ __forceinline__ float fadd_s(float a,float b){float r;asm("v_add_f32_e32 %0, %1, %2":"=v"(r):"v"(a),"v"(b));return r;}
__device__ __forceinline__ float fsub_s(float a,float b){float r;asm("v_sub_f32_e32 %0, %1, %2":"=v"(r):"v"(a),"v"(b));return r;}
typedef float f32x2_t __attribute__((ext_vector_type(2))); typedef __bf16 bf16x2_t __attribute__((ext_vector_type(2)));
__device__ __forceinline__ unsigned cvtpk_s(float lo,float hi){f32x2_t v={lo,hi};bf16x2_t b=__builtin_convertvector(v,bf16x2_t);return __builtin_bit_cast(unsigned,b);}
#define WAIT_BAR(N) asm volatile("s_waitcnt vmcnt(" #N ") lgkmcnt(0)\n\ts_barrier":::"memory")

__device__ __forceinline__ void qkt(f32x16&p0,f32x16&p1,const char*Kslot,const bf16x8*qr,const f32x16&negm,int r32,int hi){
  const char*kb=Kslot+hi*1024+r32*16;
  #pragma unroll
  for(int d0=0;d0<4;++d0){
    const bf16x8 b0=*reinterpret_cast<const bf16x8*>(kb+d0*2048);
    const bf16x8 b1=*reinterpret_cast<const bf16x8*>(kb+d0*2048+512);
    if(d0==0){p0=__builtin_amdgcn_mfma_f32_32x32x16_bf16(b0,qr[0],negm,0,0,0);p1=__builtin_amdgcn_mfma_f32_32x32x16_bf16(b1,qr[0],negm,0,0,0);}
    else{p0=__builtin_amdgcn_mfma_f32_32x32x16_bf16(b0,qr[d0],p0,0,0,0);p1=__builtin_amdgcn_mfma_f32_32x32x16_bf16(b1,qr[d0],p1,0,0,0);}}
}
typedef __attribute__((address_space(3))) const char* lds_cptr;
typedef short v4i16_t __attribute__((ext_vector_type(4)));
__device__ __forceinline__ void kload8(bf16x8*kf,lds_cptr kp){
  kf[0]=*(const __attribute__((address_space(3))) bf16x8*)(kp);      kf[1]=*(const __attribute__((address_space(3))) bf16x8*)(kp+512);
  kf[2]=*(const __attribute__((address_space(3))) bf16x8*)(kp+2048); kf[3]=*(const __attribute__((address_space(3))) bf16x8*)(kp+2560);
  kf[4]=*(const __attribute__((address_space(3))) bf16x8*)(kp+4096); kf[5]=*(const __attribute__((address_space(3))) bf16x8*)(kp+4608);
  kf[6]=*(const __attribute__((address_space(3))) bf16x8*)(kp+6144); kf[7]=*(const __attribute__((address_space(3))) bf16x8*)(kp+6656);
}
__device__ __forceinline__ void kload2(bf16x8*kf,lds_cptr kp,int j){ kf[2*j]=*(const __attribute__((address_space(3))) bf16x8*)(kp+j*2048); kf[2*j+1]=*(const __attribute__((address_space(3))) bf16x8*)(kp+j*2048+512); }
__device__ __forceinline__ s16x4 vtr(lds_cptr p){ return __builtin_bit_cast(s16x4,__builtin_amdgcn_ds_read_tr16_b64_v4i16((__attribute__((address_space(3))) v4i16_t*)p)); }
__device__ __forceinline__ float rowmax(const f32x16&p0,const f32x16&p1){
  float a=max3f(p0[0],p0[1],p1[0]),b=max3f(p0[2],p0[3],p1[1]);a=max3f(a,p1[2],p1[3]);
  #pragma unroll
  for(int r=4;r<16;r+=4){a=max3f(a,p0[r],p0[r+1]);b=max3f(b,p0[r+2],p0[r+3]);a=max3f(a,p1[r],p1[r+1]);b=max3f(b,p1[r+2],p1[r+3]);}
  const float m=max2f(a,b);
  auto rr=__builtin_amdgcn_permlane32_swap(__float_as_uint(m),__float_as_uint(m),false,false);
  return max2f(__uint_as_float(rr[0]),__uint_as_float(rr[1]));
}
__device__ __forceinline__ void pv(f32x16*o,int vb,bf16x8 pa0,bf16x8 pa1,bf16x8 pa2,bf16x8 pa3){
  #pragma unroll
  for(int d0=0;d0<2;++d0){s16x4 lo[4],hi[4];
    #pragma unroll
    for(int ks=0;ks<4;++ks){
      asm volatile("ds_read_b64_tr_b16 %0,%1 offset:%c2":"=&v"(lo[ks]):"v"(vb),"i"(d0*4096+ks*1024):"memory");
      asm volatile("ds_read_b64_tr_b16 %0,%1 offset:%c2":"=&v"(hi[ks]):"v"(vb),"i"(d0*4096+ks*1024+512):"memory");}
    asm volatile("s_waitcnt lgkmcnt(0)":::"memory");SBAR();
    #define PK(k) (bf16x8){lo[k][0],lo[k][1],lo[k][2],lo[k][3],hi[k][0],hi[k][1],hi[k][2],hi[k][3]}
    o[d0]=__builtin_amdgcn_mfma_f32_32x32x16_bf16(pa0,PK(0),o[d0],0,0,0);
    o[d0]=__builtin_amdgcn_mfma_f32_32x32x16_bf16(pa1,PK(1),o[d0],0,0,0);
    o[d0]=__builtin_amdgcn_mfma_f32_32x32x16_bf16(pa2,PK(2),o[d0],0,0,0);
    o[d0]=__builtin_amdgcn_mfma_f32_32x32x16_bf16(pa3,PK(3),o[d0],0,0,0);
    #undef PK
  }
}

template<int THRL,bool NBRM=false,bool DV2=false> __device__ __forceinline__ void attn_unit(const bf16*Qu,const bf16*__restrict__ Kh,const bf16*__restrict__ Vh,const int NT,const bf16*SZu,bf16*OGu,char*shm,
                                                                      const int rowoff=0,const int qrow0=0,const LAS float*rpbL=nullptr,const bf16*__restrict__ V2h=nullptr,float*Oraw=nullptr){
  constexpr int LDS_V2=LDS_BYTES, ND=DV2?4:2;
  #define WB(a,b) do{ if constexpr(DV2){WAIT_BAR(b);} else {WAIT_BAR(a);} }while(0)
  int tid=threadIdx.x; asm volatile("":"+v"(tid)); const int lane=tid&63,r32=lane&31,hi=lane>>5; const int wid=__builtin_amdgcn_readfirstlane(tid>>6);
  const bf16*Qw=Qu+(long)wid*QBLK*PQ;
  const unsigned lds0=(unsigned)(uintptr_t)shm;
  float*wsf=(float*)(shm+LDS_WS)+wid*64;
  const bf16*ksrc=Kh+(long)lane*PQ+wid*8;
  const bf16*vsrc=Vh+(long)(16*(wid&3)+(lane>>2))*PQ+(wid>>2)*32+(lane&3)*8;
  const unsigned kdst=lds0+LDS_K+wid*1024, vdst=lds0+LDS_V+wid*1024;
  #define TMAP(t) ((NBRM&&(t)>=4)?((t)+rowoff):(t))
  #define DMA_K(t,slot) glds16(ksrc+(long)TMAP(t)*KVBLK*PQ,(unsigned)__builtin_amdgcn_readfirstlane(kdst+(slot)))
  #define DMA_V(t,slot) glds16(vsrc+(long)TMAP(t)*KVBLK*PQ,(unsigned)__builtin_amdgcn_readfirstlane(vdst+(slot)))
  const bf16*v2src=DV2?V2h+(vsrc-Vh):vsrc; const unsigned v2dst=lds0+LDS_V2+wid*1024;
  #define DMA_V2(t,slot) do{ if constexpr(DV2) glds16(v2src+(long)TMAP(t)*KVBLK*PQ,(unsigned)__builtin_amdgcn_readfirstlane(v2dst+(slot))); }while(0)
  const int vb0=(int)(lds0+LDS_V)+((lane>>4)&1)*32+(lane&3)*8+(4*hi+((lane&15)>>2))*64;
  const char*Kbase=shm+LDS_K; bf16x8 kf[8];
  const lds_cptr shm3=(lds_cptr)shm; const lds_cptr kp0=shm3+LDS_K+hi*1024+r32*16; const lds_cptr vp0=shm3+LDS_V+((lane>>4)&1)*32+(lane&3)*8+(4*hi+((lane&15)>>2))*64;
  DMA_K(0,0);DMA_V(0,0);DMA_V2(0,0);DMA_K(1,SLOTB);
  bf16x8 qr[4];
  #pragma unroll
  for(int d0=0;d0<4;++d0)qr[d0]=*reinterpret_cast<const bf16x8*>(&Qw[(long)r32*PQ+d0*16+hi*8]);
  float mhat=0.f,l_reg=0.f;f32x16 o[ND];
  #pragma unroll
  for(int d_=0;d_<ND;++d_)o[d_]=f32x16{};
  f32x16 negm=f32x16{}; if constexpr(!DV2) asm volatile("":"+v"(negm));
  const f32x16 zero16=f32x16{};
  #define NEGM (DV2?zero16:negm)
  const int nq_r=qrow0+(wid>>1), nq_c=(wid&1)*32+r32, n_rsw=min(max(nq_r-4,0),56), n_cs=min(max(nq_c-8,0),48);
  #define CMASK(P0,P1,t) do{ if constexpr(NBRM){ const int t_=(t); if(t_>=4){ const int kr_=rowoff+t_-4; \
      if((unsigned)(kr_-n_rsw)>=8u){ _Pragma("unroll") for(int r=0;r<16;++r){P0[r]=-INFINITY;P1[r]=-INFINITY;} } \
      else{ const LAS float*bp_=rpbL+(kr_-nq_r+7)*31+15-nq_c; \
        _Pragma("unroll") for(int r=0;r<16;++r){ const int kc_=crow(r,hi); \
          const bool v0_=(unsigned)(kc_-n_cs)<16u, v1_=(unsigned)(kc_+32-n_cs)<16u; \
          const float b0_=v0_?bp_[kc_]:0.f, b1_=v1_?bp_[kc_+32]:0.f; \
          P0[r]=v0_?P0[r]+b0_:-INFINITY; P1[r]=v1_?P1[r]+b1_:-INFINITY; } } } } }while(0)
  bool resc=false;
  #define START(P0,P1) do{ const float rm=rowmax(P0,P1); resc=false; \
    { const float dl=rm; mhat=fadd_s(mhat,dl); \
      _Pragma("unroll") for(int r=0;r<16;++r){P0[r]=fsub_s(P0[r],dl);P1[r]=fsub_s(P1[r],dl);} \
      if constexpr(!DV2){ _Pragma("unroll") for(int r=0;r<16;++r)negm[r]=-mhat; asm volatile("":"+v"(negm)); } } \
    _Pragma("unroll") for(int r=0;r<16;++r)P0[r]=__builtin_amdgcn_exp2f(P0[r]); }while(0)
  #define RESC() do{ if(resc){ asm volatile("s_waitcnt lgkmcnt(0)":::"memory"); \
      _Pragma("unroll") for(int d_=0;d_<ND;++d_) _Pragma("unroll") for(int r=0;r<16;++r)o[d_][r]*=wsf[crow(r,hi)]; } }while(0)
  f32x16 pA0,pA1,pB0,pB1;
  int sl_prev=0,sl_cur=0,sl_next=SLOTB;
  #define ROT() do{sl_prev=sl_cur;sl_cur=sl_next;sl_next=(sl_next==(NSLOT-1)*SLOTB)?0:sl_next+SLOTB;}while(0)
  DMA_K(2,2*SLOTB);
  WB(3,4);
  qkt(pA0,pA1,Kbase,qr,NEGM,r32,hi);asm volatile("s_nop 15\n\ts_nop 7":"+v"(pA0),"+v"(pA1));CMASK(pA0,pA1,0);
  START(pA0,pA1);
  _Pragma("unroll") for(int r=0;r<16;++r)pA1[r]=__builtin_amdgcn_exp2f(pA1[r]);
  WAIT_BAR(0);
  DMA_K(3,0);DMA_V(1,SLOTB);DMA_V2(1,SLOTB);
  ROT();
  kload8(kf,kp0+sl_cur);
  WB(2,3);
  s16x4 vlo[8],vhi[8]; u32x4 pw0,pw1,pw2,pw3;
  #define PKW(P,B) cvtpk_s(P[B],P[B+1])
  #define PAF(k) __builtin_bit_cast(bf16x8,pw##k)
  #define VFR(i) (bf16x8){vlo[i][0],vlo[i][1],vlo[i][2],vlo[i][3],vhi[i][0],vhi[i][1],vhi[i][2],vhi[i][3]}
  #define PIN(x) asm volatile("":"+v"(x))
  #define MX3(a,b,c) __builtin_fmaxf(__builtin_fmaxf((a),(b)),(c))
  #define GAPA(MF,A0,A1,A2,A3,W0,W1,PW) do{ MF; sacc+=A0; sacc+=A1; sacc+=A2; sacc+=A3; PIN(sacc); W0; W1; PIN(PW); SBAR(); }while(0)
  #define EX(v) (DV2?__builtin_amdgcn_exp2f((v)-mhat):__builtin_amdgcn_exp2f(v))
  #define GAPB(MF,X,B) do{ MF; X[B]=EX(X[B]); X[B+1]=EX(X[B+1]); X[B+2]=EX(X[B+2]); X[B+3]=EX(X[B+3]); PIN(X); SBAR(); }while(0)
  #define GAPH(MF,X,B) do{ MF; X[B]=EX(X[B]); X[B+1]=EX(X[B+1]); PIN(X); SBAR(); }while(0)
  #define GAPX(MF,XA,BA,XH,BH) do{ if constexpr(DV2){ GAPH(MF,XH,BH); } else { GAPB(MF,XA,BA); } }while(0)
  #define VRD(i) do{ vlo[i]=vtr(vp_+(((i)>>2)*4096+((i)&3)*1024)); vhi[i]=vtr(vp_+(((i)>>2)*4096+((i)&3)*1024+512)); }while(0)
  #define KRD(G,j) do{ if(G){ kload2(kf,kp0+sl_next,j); SBAR(); } }while(0)
  #define KRD1(G,j) do{ if constexpr(!DV2){ KRD(G,j); } }while(0)
  #define V2R(i) do{ if constexpr(DV2){ vlo[i]=vtr(vq_+(((i)>>2)*4096+((i)&3)*1024)); vhi[i]=vtr(vq_+(((i)>>2)*4096+((i)&3)*1024+512)); SBAR(); } }while(0)
  #define STEP(C0,C1,P0,P1,t,GK,GV,GL) do{ SBAR(); \
    const lds_cptr vp_=vp0+sl_prev; const lds_cptr vq_=vp0+(LDS_V2-LDS_V)+sl_prev; (void)vq_; \
    VRD(0); SBAR(); float sacc=(P0[0]+P0[1]); \
    GAPA(C0=__builtin_amdgcn_mfma_f32_32x32x16_bf16(kf[0],qr[0],NEGM,0,0,0), P0[2],P0[3],P0[4],P0[5],     pw0[0]=PKW(P0,0), pw0[1]=PKW(P0,2), pw0); \
    VRD(4); SBAR(); GAPA(C1=__builtin_amdgcn_mfma_f32_32x32x16_bf16(kf[1],qr[0],NEGM,0,0,0), P0[6],P0[7],P0[8],P0[9],     pw0[2]=PKW(P0,4), pw0[3]=PKW(P0,6), pw0); \
    VRD(1); SBAR(); GAPA(C0=__builtin_amdgcn_mfma_f32_32x32x16_bf16(kf[2],qr[1],C0,0,0,0),   P0[10],P0[11],P0[12],P0[13], pw1[0]=PKW(P0,8), pw1[1]=PKW(P0,10), pw1); \
    VRD(5); SBAR(); GAPA(C1=__builtin_amdgcn_mfma_f32_32x32x16_bf16(kf[3],qr[1],C1,0,0,0),   P0[14],P0[15],P1[0],P1[1],   pw1[2]=PKW(P0,12),pw1[3]=PKW(P0,14), pw1); \
    VRD(2); SBAR(); GAPA(C0=__builtin_amdgcn_mfma_f32_32x32x16_bf16(kf[4],qr[2],C0,0,0,0),   P1[2],P1[3],P1[4],P1[5],     pw2[0]=PKW(P1,0), pw2[1]=PKW(P1,2), pw2); \
    VRD(6); SBAR(); GAPA(C1=__builtin_amdgcn_mfma_f32_32x32x16_bf16(kf[5],qr[2],C1,0,0,0),   P1[6],P1[7],P1[8],P1[9],     pw2[2]=PKW(P1,4), pw2[3]=PKW(P1,6), pw2); \
    VRD(3); SBAR(); GAPA(C0=__builtin_amdgcn_mfma_f32_32x32x16_bf16(kf[6],qr[3],C0,0,0,0),   P1[10],P1[11],P1[12],P1[13], pw3[0]=PKW(P1,8), pw3[1]=PKW(P1,10), pw3); \
    VRD(7); SBAR(); GAPA(C1=__builtin_amdgcn_mfma_f32_32x32x16_bf16(kf[7],qr[3],C1,0,0,0),   P1[14],P1[15],0.f,0.f,       pw3[2]=PKW(P1,12),pw3[3]=PKW(P1,14), pw3); \
    l_reg+=sacc; \
    if(GK){DMA_K((t)+3,sl_cur);} if(GV){DMA_V((t)+1,sl_next);DMA_V2((t)+1,sl_next);} \
    CMASK(C0,C1,t); \
    { float a=MX3(C0[0],C0[1],C1[0]),b=MX3(C0[2],C0[3],C1[1]); a=MX3(a,C1[2],C1[3]); \
      _Pragma("unroll") for(int r=4;r<16;r+=4){a=MX3(a,C0[r],C0[r+1]);b=MX3(b,C0[r+2],C0[r+3]);a=MX3(a,C1[r],C1[r+1]);b=MX3(b,C1[r+2],C1[r+3]);} \
      float rm=__builtin_fmaxf(a,b); { auto rr=__builtin_amdgcn_permlane32_swap(__float_as_uint(rm),__float_as_uint(rm),false,false); rm=__builtin_fmaxf(__uint_as_float(rr[0]),__uint_as_float(rr[1])); } \
      if constexpr(DV2) rm-=mhat; \
      resc=false; \
      if(__builtin_expect(__any(rm>(float)THRL),0)){ const float dl=__builtin_fmaxf(rm,0.f); mhat+=dl; \
        if constexpr(!DV2){ _Pragma("unroll") for(int r=0;r<16;++r){C0[r]-=dl;C1[r]-=dl;} } \
        if constexpr(!DV2){ _Pragma("unroll") for(int r=0;r<16;++r)negm[r]=-mhat; asm volatile("":"+v"(negm)); } \
        const float f=__builtin_amdgcn_exp2f(-dl); l_reg*=f; if(hi==0)wsf[r32]=f; resc=true; } } \
    SBAR(); \
    GAPX(o[0]=__builtin_amdgcn_mfma_f32_32x32x16_bf16(PAF(0),VFR(0),o[0],0,0,0), C0,0,  C0,0); V2R(0); \
    GAPX(o[1]=__builtin_amdgcn_mfma_f32_32x32x16_bf16(PAF(0),VFR(4),o[1],0,0,0), C0,4,  C0,2); V2R(4); \
    KRD1(GL,0); GAPX(o[0]=__builtin_amdgcn_mfma_f32_32x32x16_bf16(PAF(1),VFR(1),o[0],0,0,0), C0,8,  C0,4); V2R(1); \
    KRD1(GL,1); GAPX(o[1]=__builtin_amdgcn_mfma_f32_32x32x16_bf16(PAF(1),VFR(5),o[1],0,0,0), C0,12, C0,6); V2R(5); \
    KRD1(GL,2); GAPX(o[0]=__builtin_amdgcn_mfma_f32_32x32x16_bf16(PAF(2),VFR(2),o[0],0,0,0), C1,0,  C0,8); V2R(2); \
    KRD1(GL,3); GAPX(o[1]=__builtin_amdgcn_mfma_f32_32x32x16_bf16(PAF(2),VFR(6),o[1],0,0,0), C1,4,  C0,10); V2R(6); \
    GAPX(o[0]=__builtin_amdgcn_mfma_f32_32x32x16_bf16(PAF(3),VFR(3),o[0],0,0,0), C1,8,  C0,12); V2R(3); \
    GAPX(o[1]=__builtin_amdgcn_mfma_f32_32x32x16_bf16(PAF(3),VFR(7),o[1],0,0,0), C1,12, C0,14); V2R(7); \
    if constexpr(DV2){ \
      GAPH(o[ND-2]=__builtin_amdgcn_mfma_f32_32x32x16_bf16(PAF(0),VFR(0),o[ND-2],0,0,0), C1,0); \
      GAPH(o[ND-1]=__builtin_amdgcn_mfma_f32_32x32x16_bf16(PAF(0),VFR(4),o[ND-1],0,0,0), C1,2); \
      KRD(GL,0); GAPH(o[ND-2]=__builtin_amdgcn_mfma_f32_32x32x16_bf16(PAF(1),VFR(1),o[ND-2],0,0,0), C1,4); \
      KRD(GL,1); GAPH(o[ND-1]=__builtin_amdgcn_mfma_f32_32x32x16_bf16(PAF(1),VFR(5),o[ND-1],0,0,0), C1,6); \
      KRD(GL,2); GAPH(o[ND-2]=__builtin_amdgcn_mfma_f32_32x32x16_bf16(PAF(2),VFR(2),o[ND-2],0,0,0), C1,8); \
      KRD(GL,3); GAPH(o[ND-1]=__builtin_amdgcn_mfma_f32_32x32x16_bf16(PAF(2),VFR(6),o[ND-1],0,0,0), C1,10); \
      GAPH(o[ND-2]=__builtin_amdgcn_mfma_f32_32x32x16_bf16(PAF(3),VFR(3),o[ND-2],0,0,0), C1,12); \
      GAPH(o[ND-1]=__builtin_amdgcn_mfma_f32_32x32x16_bf16(PAF(3),VFR(7),o[ND-1],0,0,0), C1,14); } \
    }while(0)
  int t=1;
  for(;t+5<NT;t+=2){
    STEP(pB0,pB1,pA0,pA1,t,true,true,true);     WB(2,3); RESC(); ROT();
    STEP(pA0,pA1,pB0,pB1,t+1,true,true,true);   WB(2,3); RESC(); ROT();
  }
  #define ENDW(tt) do{ if((tt)+3<NT){WB(2,3);} else if((tt)+2<NT){WB(1,2);} else {WAIT_BAR(0);} }while(0)
  for(;t+1<NT;t+=2){
    STEP(pB0,pB1,pA0,pA1,t,(t+3<NT),(t+1<NT),(t+1<NT));       ENDW(t);   RESC(); ROT();
    STEP(pA0,pA1,pB0,pB1,t+1,(t+4<NT),(t+2<NT),(t+2<NT));     ENDW(t+1); RESC(); ROT();
  }
  STEP(pB0,pB1,pA0,pA1,NT-1,false,false,false); RESC();
  { float sacc=pB0[0]+pB0[1]; _Pragma("unroll") for(int r=2;r<16;++r)sacc+=pB0[r]; _Pragma("unroll") for(int r=0;r<16;++r)sacc+=pB1[r]; l_reg+=sacc;
    pw0=(u32x4){PKW(pB0,0),PKW(pB0,2),PKW(pB0,4),PKW(pB0,6)};pw1=(u32x4){PKW(pB0,8),PKW(pB0,10),PKW(pB0,12),PKW(pB0,14)};pw2=(u32x4){PKW(pB1,0),PKW(pB1,2),PKW(pB1,4),PKW(pB1,6)};pw3=(u32x4){PKW(pB1,8),PKW(pB1,10),PKW(pB1,12),PKW(pB1,14)};
    SBAR(); pv(o,vb0+sl_cur,PAF(0),PAF(1),PAF(2),PAF(3)); if constexpr(DV2) pv(o+2,vb0+(LDS_V2-LDS_V)+sl_cur,PAF(0),PAF(1),PAF(2),PAF(3)); }
  #undef PKW
  #undef PAF
  #undef VFR
  #undef PIN
  #undef MX3
  #undef GAPA
  #undef GAPB
  #undef GAPH
  #undef GAPX
  #undef EX
  #undef VRD
  #undef KRD
  #undef KRD1
  #undef V2R
  #undef STEP
  #undef ENDW
  {auto rr=__builtin_amdgcn_permlane32_swap(__float_as_uint(l_reg),__float_as_uint(l_reg),false,false);l_reg=__uint_as_float(rr[0])+__uint_as_float(rr[1]);}
  if(hi==0)wsf[32+r32]=l_reg;asm volatile("s_waitcnt lgkmcnt(0)":::"memory");
  float rli[16];
  #pragma unroll
  for(int r=0;r<16;++r)rli[r]=__builtin_amdgcn_rcpf(wsf[32+crow(r,hi)]);
  if constexpr(DV2){ float*Orw=Oraw+(long)wid*QBLK*128;
    #pragma unroll
    for(int r=0;r<16;++r){const int orow=crow(r,hi);
      #pragma unroll
      for(int d0=0;d0<4;++d0) Orw[orow*128+d0*32+r32]=o[d0][r]*rli[r];}
  } else {
  bf16*Ow=OGu+(long)wid*QBLK*1024; const bf16*Zw=SZu+(long)wid*QBLK*1024;
  { bf16*stg=(bf16*)(shm+LDS_OST)+wid*2048;
    #pragma unroll
    for(int r=0;r<16;++r){const int orow=crow(r,hi);
      #pragma unroll
      for(int d0=0;d0<2;++d0) stg[orow*64+d0*32+r32]=(bf16)(pk_bf16(o[d0][r]*rli[r],0.f)&0xffffu);}
    asm volatile("s_waitcnt lgkmcnt(0)":::"memory");
    #pragma unroll
    for(int i=0;i<4;++i){const int row=i*8+(lane>>3),ch=lane&7; const u32x4 v=*(const u32x4*)(stg+row*64+ch*8); const u32x4 z=*(const u32x4*)(Zw+(long)row*1024+ch*8); u32x4 g;
      #pragma unroll
      for(int e=0;e<4;++e){ const float a0=__uint_as_float(v[e]<<16)*__uint_as_float(z[e]<<16), a1=__uint_as_float(v[e]&0xffff0000u)*__uint_as_float(z[e]&0xffff0000u); g[e]=pk_bf16(a0,a1); }
      *(u32x4*)(Ow+(long)row*1024+ch*8)=g;} }
  }
  asm volatile("s_waitcnt lgkmcnt(0)\n\ts_barrier":::"memory");
  #undef DMA_K
  #undef DMA_V2
  #undef NEGM
  #undef WB
  #undef TMAP
  #undef DMA_V
  #undef CMASK
  #undef START
  #undef RESC
  #undef ROT
}
#undef SBAR
#undef WAIT_BAR
}

constexpr int ATT_BUF = 64 * LDT + 128 * LDT;
template <int NDB, bool NBR>
__device__ __forceinline__ void attn_pass(const int tid, const bf16_t* __restrict__ Qrow, const bf16_t* __restrict__ Kb, const bf16_t* __restrict__ Vb,
                                          int ntiles, int rs0, int qr, int qc, int rsw, const float* srpb,
                                          bf16_t* sbase, f32x16 (&O)[NDB], float& lsum_out) {
    const int lane = tid & 63, lr = lane & 31, lh = lane >> 5;
    const int lrow = tid >> 3, lpart = tid & 7;
    constexpr int NV = NDB / 2;
    bf16x8 qf[4];
#pragma unroll
    for (int s = 0; s < 4; ++s) qf[s] = *(const bf16x8*)(Qrow + s * 16);
#pragma unroll
    for (int db = 0; db < NDB; ++db)
#pragma unroll
        for (int i = 0; i < 16; ++i) O[db][i] = 0.f;
    float m = -1e30f, lsum = 0.f;
    u32x4 kreg, vreg[NV];
    auto key0_of = [&](int it) -> int { return (NBR && it >= 4) ? (CTXL + (rs0 + it - 4) * 64) : it * 64; };
    auto gload = [&](int it) {
        const int key0 = key0_of(it);
        kreg = *(const u32x4*)(Kb + (size_t)(key0 + lrow) * 64 + lpart * 8);
#pragma unroll
        for (int j = 0; j < NV; ++j) vreg[j] = *(const u32x4*)(Vb + (size_t)(lrow + 64 * j) * TT + key0 + lpart * 8);
    };
    auto swrite = [&](int buf) {
        bf16_t* sb = sbase + buf * ATT_BUF;
        *(u32x4*)(sb + lrow * LDT + lpart * 8) = kreg;
#pragma unroll
        for (int j = 0; j < NV; ++j) *(u32x4*)(sb + 64 * LDT + (lrow + 64 * j) * LDT + lpart * 8) = vreg[j];
    };
    gload(0);
    __syncthreads();
    swrite(0);
    if (ntiles > 1) gload(1);
    __syncthreads();
    const int kfo = swap23(lr) * LDT + lh * 8;
    const int vfo = 64 * LDT + lr * LDT + lh * 8;
    const int cs_ = min(max(qc - 8, 0), 48);
#pragma unroll 1
    for (int it = 0; it < ntiles; ++it) {
        if (it + 1 < ntiles) swrite((it + 1) & 1);
        if (it + 2 < ntiles) gload(it + 2);
        const bf16_t* sb = sbase + (it & 1) * ATT_BUF;
        const int kr = rs0 + it - 4;
        const bool act = !NBR || it < 4 || (kr >= rsw && kr < rsw + 8);
        if (act) {
            f32x16 S[2];
#pragma unroll
            for (int sub = 0; sub < 2; ++sub) {
#pragma unroll
                for (int i = 0; i < 16; ++i) S[sub][i] = 0.f;
#pragma unroll
                for (int s = 0; s < 4; ++s) {
                    const bf16x8 kf = *(const bf16x8*)(sb + kfo + sub * 32 * LDT + s * 16);
                    S[sub] = MFMA32(kf, qf[s], S[sub]);
                }
            }
            if (NBR && it >= 4) {
                const float* bp = srpb + (kr - qr + 7) * 31 + 15 - qc;
#pragma unroll
                for (int sub = 0; sub < 2; ++sub)
#pragma unroll
                    for (int i = 0; i < 16; ++i) {
                        const int kc = sub * 32 + (i & 7) + 8 * lh + 16 * (i >> 3);
                        const bool valid = (unsigned)(kc - cs_) < 16u;
                        const float bias = valid ? bp[kc] : 0.f;
                        S[sub][i] = valid ? S[sub][i] + bias : -1e30f;
                    }
            }
            float mx = S[0][0];
#pragma unroll
            for (int i = 1; i < 16; ++i) mx = fmaxf(mx, S[0][i]);
#pragma unroll
            for (int i = 0; i < 16; ++i) mx = fmaxf(mx, S[1][i]);
            mx = fmaxf(mx, __shfl_xor(mx, 32));
            const bool need = mx > m;
            {
                const float mnew = need ? mx : m;
                const float alpha = fast_exp2(m - mnew);
                m = mnew;
                lsum *= alpha;
#pragma unroll
                for (int db = 0; db < NDB; ++db)
#pragma unroll
                    for (int i = 0; i < 16; ++i) O[db][i] *= alpha;
            }
            float rs = 0.f;
#pragma unroll
            for (int sub = 0; sub < 2; ++sub)
#pragma unroll
                for (int i = 0; i < 16; ++i) { const float pv = fast_exp2(S[sub][i] - m); S[sub][i] = pv; rs += pv; }
            lsum += rs;
#pragma unroll
            for (int sub = 0; sub < 2; ++sub)
#pragma unroll
                for (int s2 = 0; s2 < 2; ++s2) {
                    u32x4 pw;
                    pw.x = pk_bf16(S[sub][8 * s2 + 0], S[sub][8 * s2 + 1]); pw.y = pk_bf16(S[sub][8 * s2 + 2], S[sub][8 * s2 + 3]);
                    pw.z = pk_bf16(S[sub][8 * s2 + 4], S[sub][8 * s2 + 5]); pw.w = pk_bf16(S[sub][8 * s2 + 6], S[sub][8 * s2 + 7]);
                    const bf16x8 pf = __builtin_bit_cast(bf16x8, pw);
#pragma unroll
                    for (int db = 0; db < NDB; ++db) {
                        const bf16x8 vf = *(const bf16x8*)(sb + vfo + db * 32 * LDT + (sub * 2 + s2) * 16);
                        O[db] = MFMA32(vf, pf, O[db]);
                    }
                }
        }
        __syncthreads();
    }
    lsum_out = lsum + __shfl_xor(lsum, 32);
}

template <int NDB>
__device__ __forceinline__ void attn_store(const Params& p, int row, int col0, const f32x16 (&O)[NDB], int lh) {
    const bf16_t* szr = p.sz + (size_t)row * D + col0;
    bf16_t* ogr = p.og + (size_t)row * D + col0;
#pragma unroll
    for (int db = 0; db < NDB; ++db)
#pragma unroll
        for (int g4 = 0; g4 < 4; ++g4) {
            const int d0 = db * 32 + 8 * g4 + 4 * lh;
            const u32x2 zz = *(const u32x2*)(szr + d0);
            const float z0 = __uint_as_float(zz.x << 16), z1 = __uint_as_float(zz.x & 0xffff0000u);
            const float z2 = __uint_as_float(zz.y << 16), z3 = __uint_as_float(zz.y & 0xffff0000u);
            u32x2 o; o.x = pk_bf16(O[db][4 * g4 + 0] * z0, O[db][4 * g4 + 1] * z1); o.y = pk_bf16(O[db][4 * g4 + 2] * z2, O[db][4 * g4 + 3] * z3);
            *(u32x2*)(ogr + d0) = o;
        }
}

__device__ __forceinline__ void phase_attn(const Params& p, int l, unsigned char* smem) {
    const int kind = l % 3;
    const bool need_ctx = l < 3;
    bf16_t* sbase = (bf16_t*)smem; float* srpb = (float*)(sbase + 2 * ATT_BUF);
    int tid = threadIdx.x; asm volatile("" : "+v"(tid));
    const int lane = tid & 63, w = tid >> 6, lr = lane & 31, lh = lane >> 5;
    const int b = blockIdx.x & 7, xj = blockIdx.x >> 3, xn = gridDim.x >> 3;
    if (kind == 0) {
        const int nlat = 16 * 16, nctx = need_ctx ? 16 : 0;
        for (int li = xj; li < nlat + nctx; li += xn) {
            int head, qb; const bool isctx = li >= nlat;
            if (!isctx) { qb = li & 15; head = li >> 4; } else { qb = 0; head = li - nlat; }
            const int kh = head >> 2;
            const bf16_t* Qu = p.q + (((size_t)b * 16 + head) * TT + (isctx ? 0 : CTXL + qb * 256)) * 64;
            const bf16_t* Kh = p.k + ((size_t)b * 4 + kh) * TT * 64;
            const bf16_t* Vh = p.vt + ((size_t)b * 4 + kh) * TT * 64;
            const size_t grow0 = isctx ? (size_t)MLAT + b * CTXL : (size_t)b * SEQ + qb * 256;
            attn_a::attn_unit<8>(Qu, Kh, Vh, isctx ? 4 : TT / 64, p.sz + grow0 * D + head * 64, p.og + grow0 * D + head * 64, (char*)smem);
        }
    } else if (kind == 1) {
        const int nlat = 16 * 16, nctx = need_ctx ? 16 : 0;
        LAS float* rpbL = (LAS float*)((LAS unsigned char*)smem + 90112);
        for (int li = xj; li < nlat + nctx; li += xn) {
            int head, qb; const bool isctx = li >= nlat;
            if (!isctx) { qb = li & 15; head = li >> 4; } else { qb = 0; head = li - nlat; }
            const bf16_t* Qu = p.q + (((size_t)b * 16 + head) * TT + (isctx ? 0 : CTXL + qb * 256)) * 64;
            const bf16_t* Kh = p.k + ((size_t)b * 16 + head) * TT * 64;
            const bf16_t* Vh = p.vt + ((size_t)b * 16 + head) * TT * 64;
            const size_t grow0 = isctx ? (size_t)MLAT + b * CTXL : (size_t)b * SEQ + qb * 256;
            if (!isctx) {
                const int rstart = min(min(max(4 * qb - 4, 0), 56), 52);
                for (int idx = tid; idx < 465; idx += NTHR) rpbL[idx] = p.rpb[head * 465 + idx] * LOG2E;
                attn_a::attn_unit<8, true>(Qu, Kh, Vh, 16, p.sz + grow0 * D + head * 64, p.og + grow0 * D + head * 64, (char*)smem, rstart, 4 * qb, rpbL);
            } else {
                attn_a::attn_unit<8, false>(Qu, Kh, Vh, 4, p.sz + grow0 * D + head * 64, p.og + grow0 * D + head * 64, (char*)smem);
            }
        }
    } else {
        const float lam = p.lam[0];
        const float post = 1.0f - p.lam_init;
        float* blk = p.scr + (size_t)blockIdx.x * (2 * 256 * 128);
        const int nlat = 8 * 16, nctx = need_ctx ? 8 : 0;
        for (int li = xj; li < nlat + nctx; li += xn) {
            int hh, qb; const bool isctx = li >= nlat;
            if (!isctx) { qb = li & 15; hh = li >> 4; } else { qb = 0; hh = li - nlat; }
            const int qpos0 = isctx ? 0 : CTXL + qb * 256;
            const size_t grow0 = isctx ? (size_t)MLAT + b * CTXL : (size_t)b * SEQ + qb * 256;
            const int nt = isctx ? 4 : TT / 64;
            const bf16_t* Va = p.vt + ((size_t)b * 16 + hh * 2) * TT * 64;
            const bf16_t* Vb = p.vt + ((size_t)b * 16 + hh * 2 + 1) * TT * 64;
#pragma unroll 1
            for (int mm = 0; mm < 2; ++mm) {
                const bf16_t* Qu = p.q + (((size_t)b * 16 + hh * 2 + mm) * TT + qpos0) * 64;
                const bf16_t* Kh = p.k + ((size_t)b * 16 + hh * 2 + mm) * TT * 64;
                attn_a::attn_unit<8, false, true>(Qu, Kh, Va, nt, nullptr, nullptr, (char*)smem, 0, 0, nullptr, Vb, blk + mm * (256 * 128));
            }
            __syncthreads();
            const float g0 = p.subln_g[lane * 2], g1 = p.subln_g[lane * 2 + 1];
#pragma unroll 8
            for (int i = 0; i < 32; ++i) {
                const int qrow = w * 32 + i;
                const float2 a0 = *(const float2*)(blk + (size_t)qrow * 128 + lane * 2);
                const float2 a1 = *(const float2*)(blk + (size_t)(256 + qrow) * 128 + lane * 2);
                const unsigned zz = *(const unsigned*)(p.sz + (grow0 + qrow) * D + hh * 128 + lane * 2);
                const float o0 = a0.x - lam * a1.x, o1 = a0.y - lam * a1.y;
                float ss = o0 * o0 + o1 * o1;
                ss = wave_sum64(ss);
                const float rstd = rsqrtf(ss * (1.0f / 128.0f) + EPS) * post;
                const float z0 = __uint_as_float(zz << 16), z1 = __uint_as_float(zz & 0xffff0000u);
                *(unsigned*)(p.og + (grow0 + qrow) * D + hh * 128 + lane * 2) = pk_bf16(o0 * rstd * g0 * z0, o1 * rstd * g1 * z1);
            }
            __syncthreads();
        }
    }
}

__device__ __forceinline__ void grid_barrier(unsigned* ctr, unsigned target) {
    asm volatile("s_waitcnt vmcnt(0)" ::: "memory");
    __syncthreads();
    if (threadIdx.x == 0) {
        __builtin_amdgcn_fence(__ATOMIC_RELEASE, "agent");
        asm volatile("s_waitcnt vmcnt(0)" ::: "memory");
        __hip_atomic_fetch_add(ctr, 1u, __ATOMIC_RELAXED, __HIP_MEMORY_SCOPE_AGENT);
        while (__hip_atomic_load(ctr, __ATOMIC_RELAXED, __HIP_MEMORY_SCOPE_AGENT) < target) __builtin_amdgcn_s_sleep(1);
        __builtin_amdgcn_fence(__ATOMIC_ACQUIRE, "agent");
        asm volatile("s_waitcnt vmcnt(0)" ::: "memory");
    }
    __syncthreads();
}

__device__ __forceinline__ void group_barrier(unsigned* bar, unsigned target) {
    grid_barrier(bar + 64 * (1 + (blockIdx.x & 7)), target);
}

__global__ void __launch_bounds__(NTHR, 2) fwd_kernel(Params p) {
    extern __shared__ __attribute__((aligned(16))) unsigned char smem[];
    cg::grid_group grid = cg::this_grid();
    if (blockIdx.x == 0 && threadIdx.x < 9) p.bar[64 * threadIdx.x] = 0u;
    phase0(p, smem);
    grid.sync();
    unsigned tgt = 0;
    const unsigned nb = gridDim.x >> 3;
    phase_prep(p, 0, 0);
    tgt += nb; group_barrier(p.bar, tgt);
#pragma unroll 1
    for (int l = 0; l < 4; ++l) {
        phase_inproj(p, l, smem);
        tgt += nb; group_barrier(p.bar, tgt);
        phase_attn(p, l, smem);
        tgt += nb; group_barrier(p.bar, tgt);
        const int nst = l < 3 ? 3 : 1;
#pragma unroll 1
        for (int st = 0; st < nst; ++st) {
            const bool do_out = st == 0 || (st == 1 && (blockIdx.x >> 3) < 4);
            if (do_out) phase_outproj(p, l, st == 1, smem);
            else phase_prep(p, l + 1, st);
            if (l < 3) { tgt += nb; group_barrier(p.bar, tgt); }
        }
    }
}

extern "C" void kernel_launch(void* const* d_in, const int* in_sizes, int n_in, void* d_out, int out_size, void* d_ws, size_t ws_size,
                              hipStream_t stream) {
    static int grid_blocks = 0;
    if (!grid_blocks) {
        int dev = 0, cus = 0;
        (void)hipGetDevice(&dev);
        (void)hipDeviceGetAttribute(&cus, hipDeviceAttributeMultiprocessorCount, dev);
        if (hipFuncSetAttribute((const void*)fwd_kernel, hipFuncAttributeMaxDynamicSharedMemorySize, LDS_BYTES) != hipSuccess)
            fprintf(stderr, "hipFuncSetAttribute(max dynamic LDS) failed\n");
        (void)hipGetLastError();
        grid_blocks = cus > 0 ? (cus & ~7) : 256;
    }
    Params p{};
    p.x = (const float*)d_in[0]; p.c = (const float*)d_in[1]; p.ctx = (const float*)d_in[2]; p.c_ctx = (const float*)d_in[3];
    p.norm_g = (const float*)d_in[4]; p.ada_w = (const float*)d_in[5]; p.ada_b = (const float*)d_in[6];
    const float* a_w_in = (const float*)d_in[7]; const float* a_q_g = (const float*)d_in[8]; const float* a_k_g = (const float*)d_in[9];
    const float* a_w_out = (const float*)d_in[10];
    const float* b_w_in = (const float*)d_in[11]; const float* b_q_g = (const float*)d_in[12]; const float* b_k_g = (const float*)d_in[13];
    const float* b_w_out = (const float*)d_in[15];
    const float* c_w_in = (const float*)d_in[16]; const float* c_q_g = (const float*)d_in[17]; const float* c_k_g = (const float*)d_in[18];
    const float* c_w_out = (const float*)d_in[24];
    p.w_in[0] = a_w_in; p.w_in[1] = b_w_in; p.w_in[2] = c_w_in; p.w_in[3] = a_w_in + (size_t)1024 * 2560;
    p.w_out[0] = a_w_out; p.w_out[1] = b_w_out; p.w_out[2] = c_w_out; p.w_out[3] = a_w_out + (size_t)1024 * 1024;
    p.q_g[0] = a_q_g; p.q_g[1] = b_q_g; p.q_g[2] = c_q_g; p.q_g[3] = a_q_g + 64;
    p.k_g[0] = a_k_g; p.k_g[1] = b_k_g; p.k_g[2] = c_k_g; p.k_g[3] = a_k_g + 64;
    p.rpb = (const float*)d_in[14];
    p.lq1 = (const float*)d_in[19]; p.lk1 = (const float*)d_in[20]; p.lq2 = (const float*)d_in[21]; p.lk2 = (const float*)d_in[22];
    p.subln_g = (const float*)d_in[23];
    p.out = (float*)d_out;
    char* ws = (char*)d_ws; size_t off = 0;
    auto take = [&](size_t bytes) { char* r = ws + off; off += (bytes + 255) & ~(size_t)255; return r; };
    p.xb = (float*)take((size_t)MCTX * D * 4);
    p.h = (bf16_t*)take((size_t)MTOT * D * 2);
    p.q = (bf16_t*)take((size_t)NB * 16 * TT * 64 * 2);
    p.k = (bf16_t*)take((size_t)NB * 16 * TT * 64 * 2);
    p.vt = (bf16_t*)take((size_t)NB * 1024 * TT * 2);
    p.sz = (bf16_t*)take((size_t)MTOT * D * 2);
    p.og = p.h;
    for (int l = 0; l < 4; ++l) { const int N = (l == 0 || l == 3) ? 2560 : 4096; p.wt_in[l] = (bf16_t*)take((size_t)N * 1024 * 2); }
    for (int l = 0; l < 4; ++l) p.wt_out[l] = (bf16_t*)take((size_t)1024 * 1024 * 2);
    p.mod = (float*)take((size_t)4 * 9 * 3072 * 4);
    p.rope = (float*)take(64 * 16 * 2 * 4);
    p.lam = (float*)take(256);
    p.bar = (unsigned*)take(4096);
    p.scr = (float*)take((size_t)256 * 2 * 256 * 128 * 4);
    if (off > ws_size) { fprintf(stderr, "workspace too small: need %zu have %zu\n", off, ws_size); return; }
    p.lam_init = (float)(0.8 - 0.6 * std::exp(-0.3 * 2.0));
    p.pad0 = 0.f;
    void* args[] = {&p};
    hipError_t e = hipLaunchCooperativeKernel((void*)fwd_kernel, dim3(grid_blocks), dim3(NTHR), args, LDS_BYTES, stream);
    if (e != hipSuccess) fprintf(stderr, "cooperative launch failed: %s (grid %d)\n", hipGetErrorString(e), grid_blocks);
}
```

```cpp
#include <hip/hip_runtime.h>
#include <hip/hip_cooperative_groups.h>
#include <cstdio>
#include <cmath>
namespace cg = cooperative_groups;

typedef unsigned short bf16_t;
constexpr float LOG2E_ = 1.4426950408889634f;
typedef short bf16x8 __attribute__((ext_vector_type(8)));
typedef float f32x16 __attribute__((ext_vector_type(16)));
typedef float f32x4 __attribute__((ext_vector_type(4)));
typedef unsigned u32x4 __attribute__((ext_vector_type(4)));
typedef unsigned u32x2 __attribute__((ext_vector_type(2)));
#define LAS __attribute__((address_space(3)))

#define MFMA32(a, b, c) __builtin_amdgcn_mfma_f32_32x32x16_bf16((a), (b), (c), 0, 0, 0)

constexpr int D = 1024, NB = 8, SEQ = 4096, CTXL = 256, TT = SEQ + CTXL;
constexpr int MLAT = NB * SEQ, MCTX = NB * CTXL, MTOT = MLAT + MCTX;
constexpr int LDT = 72;
constexpr int NTHR = 512;
constexpr int LDS_BYTES = 158208;
constexpr float LOG2E = 1.4426950408889634f;
constexpr float QSCALE = 0.125f * LOG2E;
constexpr float EPS = 1e-6f;

__constant__ float INVF[16] = {1.0f, 0.5623413324356079f, 0.3162277638912201f, 0.17782793939113617f, 0.10000000149011612f,
    0.05623413249850273f, 0.03162277489900589f, 0.017782794311642647f, 0.009999999776482582f, 0.005623413249850273f,
    0.003162277629598975f, 0.0017782794311642647f, 0.0010000000474974513f, 0.000562341301701963f, 0.0003162277571391314f,
    0.00017782794020604342f};

struct Params {
    const float *x, *c, *ctx, *c_ctx, *norm_g, *ada_w, *ada_b;
    const float* w_in[4]; const float* w_out[4]; const float* q_g[4]; const float* k_g[4];
    const float *rpb, *lq1, *lk1, *lq2, *lk2, *subln_g;
    float* out;
    float* xb;
    bf16_t *h, *q, *k, *vt, *sz, *og;
    bf16_t* wt_in[4]; bf16_t* wt_out[4];
    float *mod, *rope, *lam, *scr;
    unsigned* bar;
    float lam_init; float pad0;
};

__device__ __forceinline__ unsigned pk_bf16(float lo, float hi) {
    unsigned r; asm("v_cvt_pk_bf16_f32 %0, %1, %2" : "=v"(r) : "v"(lo), "v"(hi)); return r;
}
__device__ __forceinline__ int swap23(int x) { return (x & 0x13) | ((x & 4) << 1) | ((x & 8) >> 1); }
__device__ __forceinline__ float fast_exp2(float x) { return __builtin_amdgcn_exp2f(x); }
__device__ __forceinline__ float wave_sum64(float v) {
    v += __uint_as_float(__builtin_amdgcn_mov_dpp(__float_as_uint(v), 0xB1, 0xF, 0xF, true));
    v += __uint_as_float(__builtin_amdgcn_mov_dpp(__float_as_uint(v), 0x4E, 0xF, 0xF, true));
    v += __uint_as_float(__builtin_amdgcn_mov_dpp(__float_as_uint(v), 0x141, 0xF, 0xF, true));
    v += __uint_as_float(__builtin_amdgcn_mov_dpp(__float_as_uint(v), 0x140, 0xF, 0xF, true));
    { auto rr = __builtin_amdgcn_permlane16_swap(__float_as_uint(v), __float_as_uint(v), false, false); v = __uint_as_float(rr[0]) + __uint_as_float(rr[1]); }
    { auto rr = __builtin_amdgcn_permlane32_swap(__float_as_uint(v), __float_as_uint(v), false, false); v = __uint_as_float(rr[0]) + __uint_as_float(rr[1]); }
    return v;
}
__device__ __forceinline__ float silu_f(float z) { return z * __builtin_amdgcn_rcpf(1.0f + __builtin_amdgcn_exp2f(-LOG2E_ * z)); }
template <typename T> __device__ __forceinline__ T sel4(T const (&a)[4], int l) { return l == 0 ? a[0] : (l == 1 ? a[1] : (l == 2 ? a[2] : a[3])); }
__host__ __device__ __forceinline__ int layer_N(int l) { return (l == 0 || l == 3) ? 2560 : 4096; }

namespace pg8 {
constexpr int BM = 256, BK = 64, HALF = 128, HTB = HALF * BK * 2, STAGE_BYTES = 8 * HTB;
__device__ __forceinline__ int lds_byte(int r, int c) { const int st = (r >> 4) * 2 + (c >> 5), rr = r & 15, cc = c & 31, ob = rr * 64 + cc * 2; return st * 1024 + (ob ^ (((ob >> 9) & 1) << 5)); }
__device__ __forceinline__ void stage_rc(int b, int& R, int& C) { const int st = b / 1024, sb = b % 1024, swz = sb ^ (((sb >> 9) & 1) << 5); R = (st >> 1) * 16 + swz / 64; C = (st & 1) * 32 + (swz % 64) / 2; }

struct Unit { const char* a; const char* b; int pm, pn, kind; };

template <class Epi, class Sched>
__device__ __forceinline__ void gemm_phase(LAS unsigned char* lds, const int K, const Sched& S, const Epi& E) {
    int tid = threadIdx.x; asm volatile("" : "+v"(tid));
    const int wid = __builtin_amdgcn_readfirstlane(tid >> 6), lane = tid & 63, wr = wid >> 2, wc = wid & 3, fr = lane & 15, fq = lane >> 4;
    const int nt = K / BK;
    unsigned voffA[2];
#pragma unroll
    for (int i = 0; i < 2; ++i) { int R, C; stage_rc(tid * 16 + i * 8192, R, C); voffA[i] = (unsigned)(R * K + C) * 2u; }
    const size_t kstep = (size_t)(BK * 2);
    const size_t hstep = (size_t)HALF * K * 2;
    const unsigned ldsw = (unsigned)wid * 1024u;
    const int aoff = lds_byte(wr * 64 + fr, fq * 8), boff = lds_byte(wc * 32 + fr, fq * 8);
#define PG8_SA(b, h) (((b) * 2 + (h)) * HTB)
#define PG8_SB(b, h) ((4 + (b) * 2 + (h)) * HTB)
#define PG8_STAGE(bufoff, gbase, voff) do { _Pragma("unroll") for (int _i = 0; _i < 2; ++_i) \
        __builtin_amdgcn_global_load_lds((const unsigned*)((const char*)(gbase) + (voff)[_i]), (LAS unsigned*)(lds + (bufoff) + ldsw + _i * 8192), 16, 0, 0); } while (0)
#define PG8_LDA(dst, b, h) do { _Pragma("unroll") for (int m = 0; m < 4; ++m) _Pragma("unroll") for (int k = 0; k < 2; ++k) dst[m][k] = *(const LAS bf16x8*)(lds + PG8_SA(b, h) + aoff + m * 2048 + k * 1024); } while (0)
#define PG8_LDB(dst, b, h) do { _Pragma("unroll") for (int n = 0; n < 2; ++n) _Pragma("unroll") for (int k = 0; k < 2; ++k) dst[n][k] = *(const LAS bf16x8*)(lds + PG8_SB(b, h) + boff + n * 2048 + k * 1024); } while (0)
#define PG8_MMA(ai, bj, At, Bt) do { __builtin_amdgcn_s_setprio(1); _Pragma("unroll") for (int m = 0; m < 4; ++m) _Pragma("unroll") for (int n = 0; n < 2; ++n) _Pragma("unroll") for (int k = 0; k < 2; ++k) \
        acc[ai][bj][m][n] = __builtin_amdgcn_mfma_f32_16x16x32_bf16(Bt[n][k], At[m][k], acc[ai][bj][m][n], 0, 0, 0); __builtin_amdgcn_s_setprio(0); } while (0)
#define PG8_WAIT_V(n) asm volatile("s_waitcnt vmcnt(" #n ")" ::: "memory")
#define PG8_WAIT_L(n) asm volatile("s_waitcnt lgkmcnt(" #n ")" ::: "memory")
#define PG8_BAR __builtin_amdgcn_s_barrier()
#define PG8_SCHED __builtin_amdgcn_sched_barrier(0)
    Unit cur, nxt; int ui = 0;
    if (!S.next(0, cur)) return;
    f32x4 acc[2][2][4][2];
#pragma unroll
    for (int a = 0; a < 2; ++a)
#pragma unroll
        for (int b = 0; b < 2; ++b)
#pragma unroll
            for (int m = 0; m < 4; ++m)
#pragma unroll
                for (int n = 0; n < 2; ++n) acc[a][b][m][n] = (f32x4){0.f, 0.f, 0.f, 0.f};
    bf16x8 At[4][2], B0[2][2], B1[2][2];
    const char* cA = cur.a; const char* cB = cur.b;
    {
        PG8_STAGE(PG8_SB(0, 0), cB, voffA); PG8_STAGE(PG8_SB(0, 1), cB + hstep, voffA); PG8_STAGE(PG8_SA(0, 0), cA, voffA); PG8_STAGE(PG8_SA(0, 1), cA + hstep, voffA);
        if (wr == 1) PG8_BAR;
        PG8_WAIT_V(2); PG8_BAR;
        PG8_STAGE(PG8_SB(1, 0), cB + kstep, voffA); PG8_STAGE(PG8_SA(1, 0), cA + kstep, voffA); PG8_STAGE(PG8_SB(1, 1), cB + hstep + kstep, voffA);
        PG8_WAIT_V(6); PG8_BAR;
    }
    for (;;) {
        const bool has_next = S.next(ui + 1, nxt);
        const char* nA = has_next ? nxt.a : cA; const char* nB = has_next ? nxt.b : cB;
        for (int t = 0; t < nt; t += 2) {
            const bool last = (t == nt - 2);
            const char* a1 = cA + (size_t)(t + 1) * kstep;
            const char* a2 = last ? nA : cA + (size_t)(t + 2) * kstep; const char* b2 = last ? nB : cB + (size_t)(t + 2) * kstep;
            const char* a3 = a2 + kstep; const char* b3 = b2 + kstep;
            PG8_LDB(B0, 0, 0); PG8_LDB(B1, 0, 1); PG8_SCHED; PG8_LDA(At, 0, 0); PG8_STAGE(PG8_SA(1, 1), a1 + hstep, voffA);
            PG8_WAIT_V(8); PG8_WAIT_L(0); PG8_BAR; PG8_MMA(0, 0, At, B0); PG8_MMA(0, 1, At, B1); PG8_BAR; PG8_SCHED;
            PG8_LDA(At, 0, 1); PG8_STAGE(PG8_SB(0, 0), b2, voffA); PG8_STAGE(PG8_SB(0, 1), b2 + hstep, voffA); PG8_STAGE(PG8_SA(0, 0), a2, voffA);
            PG8_WAIT_V(8); PG8_WAIT_L(0); PG8_BAR; PG8_MMA(1, 0, At, B0); PG8_MMA(1, 1, At, B1); PG8_BAR; PG8_SCHED;
            PG8_LDB(B0, 1, 0); PG8_LDB(B1, 1, 1); PG8_SCHED; PG8_LDA(At, 1, 0); PG8_STAGE(PG8_SA(0, 1), a2 + hstep, voffA);
            PG8_WAIT_V(8); PG8_WAIT_L(0); PG8_BAR; PG8_MMA(0, 0, At, B0); PG8_MMA(0, 1, At, B1); PG8_BAR; PG8_SCHED;
            PG8_LDA(At, 1, 1); PG8_STAGE(PG8_SB(1, 0), b3, voffA); PG8_STAGE(PG8_SB(1, 1), b3 + hstep, voffA); PG8_STAGE(PG8_SA(1, 0), a3, voffA);
            PG8_WAIT_V(8); PG8_WAIT_L(0); PG8_BAR; PG8_MMA(1, 0, At, B0); PG8_MMA(1, 1, At, B1); PG8_BAR; PG8_SCHED;
        }
        if (wr == 0) PG8_BAR;
        E(acc, cur, wr, wc, fr, fq);
        if (!has_next) break;
#pragma unroll
        for (int a = 0; a < 2; ++a)
#pragma unroll
            for (int b = 0; b < 2; ++b)
#pragma unroll
                for (int m = 0; m < 4; ++m)
#pragma unroll
                    for (int n = 0; n < 2; ++n) acc[a][b][m][n] = (f32x4){0.f, 0.f, 0.f, 0.f};
        cur = nxt; cA = nA; cB = nB; ++ui;
        if (wr == 1) PG8_BAR;
    }
    PG8_WAIT_V(0);
    PG8_BAR;
#undef PG8_SA
#undef PG8_SB
#undef PG8_STAGE
#undef PG8_LDA
#undef PG8_LDB
#undef PG8_MMA
#undef PG8_WAIT_V
#undef PG8_WAIT_L
#undef PG8_BAR
#undef PG8_SCHED
}
}

__device__ __forceinline__ bool xcd_unit(int i, int MT, int NU, int& mt, int& un) {
    int bx = blockIdx.x, gx = gridDim.x;
    asm volatile("" : "+s"(NU), "+s"(MT), "+s"(bx), "+s"(gx));
    const int xcd = bx & 7, j = bx >> 3, nbx = gx >> 3;
    const int mcount = MT >> 3;
    const int q = j + i * nbx;
    if (q >= mcount * NU) return false;
    const int g = q / (8 * NU), r = q - g * 8 * NU;
    const int gsz = min(8, mcount - g * 8);
    const int ml = g * 8 + r % gsz; un = r / gsz;
    mt = ml < 16 ? 16 * xcd + ml : MLAT / 256 + xcd;
    return true;
}

__device__ __forceinline__ void phase0(const Params& p, unsigned char* smem) {
    int tid = threadIdx.x; asm volatile("" : "+v"(tid));
    constexpr int N_ADA = 192, N_WT = 4352;
    for (int item = blockIdx.x; item < N_ADA + N_WT + 1; item += gridDim.x) {
        if (item < N_ADA) {
            float* ssc = (float*)smem;
            float* red = ssc + 9 * 1024;
            const int l = item / 48, n0 = (item % 48) * 64;
            __syncthreads();
            for (int idx = tid; idx < 9 * 1024; idx += NTHR) {
                const int v = idx >> 10, kk = idx & 1023;
                const float cv = v < 8 ? p.c[v * 1024 + kk] : p.c_ctx[kk];
                ssc[idx] = cv / (1.0f + expf(-cv));
            }
            __syncthreads();
            const int kg = tid >> 6, col = tid & 63;
            float acc[9];
#pragma unroll
            for (int v = 0; v < 9; ++v) acc[v] = 0.f;
            const float* wp = p.ada_w + ((size_t)l * 1024 + kg * 128) * 3072 + n0 + col;
#pragma unroll 8
            for (int kk = 0; kk < 128; ++kk) {
                const float w = wp[(size_t)kk * 3072];
#pragma unroll
                for (int v = 0; v < 9; ++v) acc[v] += ssc[v * 1024 + kg * 128 + kk] * w;
            }
#pragma unroll
            for (int v = 0; v < 9; ++v) red[(kg * 9 + v) * 64 + col] = acc[v];
            __syncthreads();
            for (int idx = tid; idx < 9 * 64; idx += NTHR) {
                const int v = idx >> 6, cc = idx & 63;
                float s = 0.f;
#pragma unroll
                for (int g = 0; g < 8; ++g) s += red[(g * 9 + v) * 64 + cc];
                s += p.ada_b[l * 3072 + n0 + cc];
                p.mod[((size_t)l * 9 + v) * 3072 + n0 + cc] = s;
            }
        } else if (item < N_ADA + N_WT) {
            int t = item - N_ADA;
            const float* W; bf16_t* Wt; int N; int nperm = 0;
            int l = 0; bool found = false;
#pragma unroll
            for (int m = 0; m < 4; ++m) {
                const int ntl = 16 * (layer_N(m) / 64);
                if (!found) { if (t < ntl) { l = m; found = true; } else t -= ntl; }
            }
            if (found) { W = sel4(p.w_in, l); Wt = sel4(p.wt_in, l); N = layer_N(l); nperm = 1024 + ((l == 0 || l == 3) ? 256 : 1024); }
            else { l = t / 256; t = t % 256; W = sel4(p.w_out, l); Wt = sel4(p.wt_out, l); N = 1024; }
            const int k0 = (t & 15) * 64, n0 = (t >> 4) * 64;
            float* sT = (float*)smem;
            float4 v[2];
#pragma unroll
            for (int i = 0; i < 2; ++i) {
                const int kk = (tid >> 4) + 32 * i, n4 = (tid & 15) * 4;
                v[i] = *(const float4*)(W + (size_t)(k0 + kk) * N + n0 + n4);
            }
            __syncthreads();
#pragma unroll
            for (int i = 0; i < 2; ++i) {
                const int kk = (tid >> 4) + 32 * i, n4 = (tid & 15) * 4;
                sT[(n4 + 0) * 65 + kk] = v[i].x; sT[(n4 + 1) * 65 + kk] = v[i].y;
                sT[(n4 + 2) * 65 + kk] = v[i].z; sT[(n4 + 3) * 65 + kk] = v[i].w;
            }
            __syncthreads();
            {
                const int n = tid >> 3, k8 = (tid & 7) * 8;
                const float* s = sT + n * 65 + k8;
                u32x4 o; o.x = pk_bf16(s[0], s[1]); o.y = pk_bf16(s[2], s[3]); o.z = pk_bf16(s[4], s[5]); o.w = pk_bf16(s[6], s[7]);
                int f = n0 + n;
                if (f < nperm) { const int fl = f & 255, hh = fl >> 6, d = fl & 63; f = (f & ~255) + 128 * (d >> 5) + 32 * hh + (d & 31); }
                *(u32x4*)(Wt + (size_t)f * 1024 + k0 + k8) = o;
            }
        } else {
            for (int idx = tid; idx < 1024; idx += NTHR) {
                const int pos = idx >> 4, f = idx & 15;
                const float angf = (float)pos * INVF[f];
                const double a = (double)angf;
                const double kq = rint(a * 0.63661977236758134308);
                const double r = a - kq * 1.57079632679489661923;
                const double r2 = r * r;
                double sn = r * (1.0 + r2 * (-1.0 / 6 + r2 * (1.0 / 120 + r2 * (-1.0 / 5040 + r2 * (1.0 / 362880 + r2 * (-1.0 / 39916800 + r2 * (1.0 / 6227020800.0)))))));
                double cs = 1.0 + r2 * (-0.5 + r2 * (1.0 / 24 + r2 * (-1.0 / 720 + r2 * (1.0 / 40320 + r2 * (-1.0 / 3628800 + r2 * (1.0 / 479001600.0))))));
                const int qd = ((int)kq) & 3;
                double so, co;
                if (qd == 0) { so = sn; co = cs; } else if (qd == 1) { so = cs; co = -sn; } else if (qd == 2) { so = -sn; co = -cs; } else { so = -cs; co = sn; }
                p.rope[idx * 2 + 0] = (float)co; p.rope[idx * 2 + 1] = (float)so;
            }
            if (tid == 0) {
                float d1 = 0.f, d2 = 0.f;
                for (int i = 0; i < 64; ++i) { d1 += p.lq1[i] * p.lk1[i]; d2 += p.lq2[i] * p.lk2[i]; }
                p.lam[0] = expf(d1) - expf(d2) + p.lam_init;
            }
        }
    }
}

__device__ __forceinline__ const float* xin_row(const Params& p, int l, int row) {
    if (l == 0) return row < MLAT ? p.x + (size_t)row * D : p.ctx + (size_t)(row - MLAT) * D;
    return row < MLAT ? p.out + (size_t)row * D : p.xb + (size_t)(row - MLAT) * D;
}

__device__ __forceinline__ void phase_prep(const Params& p, int l, int mode) {
    asm volatile("" : "+s"(l), "+s"(mode));
    int tid = threadIdx.x; asm volatile("" : "+v"(tid));
    const int lane = tid & 63, w = tid >> 6;
    const float* g = p.norm_g + l * D;
    const int xb_ = blockIdx.x & 7, xj_ = (int)(blockIdx.x >> 3) - (mode == 1 ? 4 : 0), xn_ = (int)(gridDim.x >> 3) - (mode == 1 ? 4 : 0);
    const int lr_lo = mode == 2 ? SEQ : 0, lr_hi = mode == 1 ? SEQ : SEQ + CTXL;
    for (int lrow = lr_lo + xj_ * 8 + w; lrow < lr_hi; lrow += xn_ * 8) {
        const int row = lrow < SEQ ? xb_ * SEQ + lrow : MLAT + xb_ * CTXL + (lrow - SEQ);
        const float* xr = xin_row(p, l, row);
        const int bv = row < MLAT ? (row >> 12) : 8;
        const float* md = p.mod + ((size_t)l * 9 + bv) * 3072;
        float4 v[4]; float ss = 0.f;
#pragma unroll
        for (int j = 0; j < 4; ++j) {
            v[j] = *(const float4*)(xr + j * 256 + lane * 4);
            ss += v[j].x * v[j].x + v[j].y * v[j].y + v[j].z * v[j].z + v[j].w * v[j].w;
        }
#pragma unroll
        for (int o = 32; o >= 1; o >>= 1) ss += __shfl_xor(ss, o);
        const float rstd = rsqrtf(ss * (1.0f / 1024.0f) + EPS);
#pragma unroll
        for (int j = 0; j < 4; ++j) {
            const int col = j * 256 + lane * 4;
            const float4 gg = *(const float4*)(g + col);
            const float4 sh = *(const float4*)(md + col);
            const float4 sc = *(const float4*)(md + 1024 + col);
            const float a0 = v[j].x * rstd * gg.x * (1.0f + sc.x) + sh.x;
            const float a1 = v[j].y * rstd * gg.y * (1.0f + sc.y) + sh.y;
            const float a2 = v[j].z * rstd * gg.z * (1.0f + sc.z) + sh.z;
            const float a3 = v[j].w * rstd * gg.w * (1.0f + sc.w) + sh.w;
            u32x2 o; o.x = pk_bf16(a0, a1); o.y = pk_bf16(a2, a3);
            *(u32x2*)(p.h + (size_t)row * D + col) = o;
        }
    }
}

struct InSched {
    const char* h; const char* wt; int nK, NU; bool vrow;
    __device__ __forceinline__ bool next(int i, pg8::Unit& u) const {
        int mt, un;
        if (!xcd_unit(i, MTOT / 256, NU, mt, un)) return false;
        u.pm = mt; u.pn = un;
        const char* hp = h + (size_t)mt * 256 * D * 2;
        const char* wp = wt + (size_t)un * 256 * D * 2;
        const int kind = un < 4 ? 0 : (un < 4 + nK ? 1 : (un < 4 + 2 * nK ? 2 : 3));
        u.kind = (kind == 2 && vrow) ? 4 : kind;
        if (u.kind == 2) { u.a = wp; u.b = hp; } else { u.a = hp; u.b = wp; }
        return true;
    }
};

struct EpiIn {
    const LAS float* ropeL; const LAS float* gL; bf16_t *q, *k, *vt, *sz; int nK; bool do_rope; LAS unsigned char* stg0;
    __device__ __forceinline__ void operator()(const f32x4 (&acc)[2][2][4][2], const pg8::Unit& u, int wr, int wc, int fr, int fq) const {
        const int row0 = u.pm * 256;
        const bool isctx = row0 >= MLAT;
        int b, t0, pos0;
        if (!isctx) { b = row0 >> 12; t0 = row0 & 4095; pos0 = CTXL + t0; } else { b = (row0 - MLAT) >> 8; t0 = 0; pos0 = 0; }
        const int lane = fr + 16 * fq, wid = wr * 4 + wc;
        LAS unsigned char* stg = stg0 + wid * 2304;
        LAS unsigned char* wp = stg + fr * 144 + fq * 8;
        const int rr = lane >> 2, ch = lane & 3;
        const LAS unsigned char* rp = stg + rr * 144 + ch * 32;
        bf16_t* dbase; size_t rpitch; int coff;
        const int kind = u.kind;
        if (kind == 3) { dbase = sz + (size_t)row0 * D + (u.pn - 4 - 2 * nK) * 256 + wc * 32; rpitch = D; coff = (ch >> 1) * 128 + (ch & 1) * 16; }
        else if (kind == 4) { const int VH = nK * 4; const int vh = (u.pn - 4 - nK) * 4 + (wc >> 1) + 2 * (ch >> 1);
            dbase = vt + (((size_t)b * VH + vh) * TT + pos0) * 64 + (wc & 1) * 32; rpitch = 64; coff = (ch & 1) * 16; }
        else if (kind == 2) { const int VF = nK * 256;
            dbase = vt + ((size_t)b * VF + (u.pn - 4 - nK) * 256) * TT + pos0 + wc * 32; rpitch = TT; coff = (ch >> 1) * 128 + (ch & 1) * 16; }
        else { const bool isq = kind == 0; const int head = isq ? u.pn * 4 + wc : (u.pn - 4) * 4 + wc;
            dbase = (isq ? q + ((size_t)b * 16 + head) * TT * 64 : k + ((size_t)b * (nK * 4) + head) * TT * 64) + (size_t)pos0 * 64; rpitch = 64; coff = ch * 16; }
        const LAS float* gp = gL + (kind == 0 ? 0 : 64);
        const float osc = kind == 0 ? QSCALE : 1.0f;
        const bool rp_on = do_rope && !isctx;
        f32x4 g4[2][2], rc[2][2], ccur[2], cnxt[2];
        if (kind <= 1) {
#pragma unroll
            for (int bj = 0; bj < 2; ++bj)
#pragma unroll
                for (int n = 0; n < 2; ++n) g4[bj][n] = *(const LAS f32x4*)(gp + 32 * bj + 16 * n + 4 * fq);
#pragma unroll
            for (int ai = 0; ai < 2; ++ai) {
                const int pos = ((t0 >> 6) + 2 * ai + wr) & 63;
                rc[ai][0] = *(const LAS f32x4*)(ropeL + (pos * 16 + 4 * fq) * 2); rc[ai][1] = *(const LAS f32x4*)(ropeL + (pos * 16 + 4 * fq) * 2 + 4);
            }
            ccur[0] = *(const LAS f32x4*)(ropeL + (fr * 16 + 4 * fq) * 2); ccur[1] = *(const LAS f32x4*)(ropeL + (fr * 16 + 4 * fq) * 2 + 4);
        }
#pragma unroll
        for (int m = 0; m < 4; ++m) {
            if (kind <= 1 && m < 3) { const int pos = (m + 1) * 16 + fr; cnxt[0] = *(const LAS f32x4*)(ropeL + (pos * 16 + 4 * fq) * 2); cnxt[1] = *(const LAS f32x4*)(ropeL + (pos * 16 + 4 * fq) * 2 + 4); }
#pragma unroll
            for (int ai = 0; ai < 2; ++ai) {
                const int tl = ai * 128 + wr * 64 + m * 16;
                u32x2 o[2][2];
                if (kind == 3) {
#pragma unroll
                    for (int bj = 0; bj < 2; ++bj)
#pragma unroll
                        for (int n = 0; n < 2; ++n) { const f32x4 v = acc[ai][bj][m][n]; o[bj][n].x = pk_bf16(silu_f(v[0]), silu_f(v[1])); o[bj][n].y = pk_bf16(silu_f(v[2]), silu_f(v[3])); }
                } else if (kind >= 2) {
#pragma unroll
                    for (int bj = 0; bj < 2; ++bj)
#pragma unroll
                        for (int n = 0; n < 2; ++n) { const f32x4 v = acc[ai][bj][m][n]; o[bj][n].x = pk_bf16(v[0], v[1]); o[bj][n].y = pk_bf16(v[2], v[3]); }
                } else {
                    float ss = 0.f;
#pragma unroll
                    for (int bj = 0; bj < 2; ++bj)
#pragma unroll
                        for (int n = 0; n < 2; ++n) { const f32x4 v = acc[ai][bj][m][n]; ss += v[0] * v[0] + v[1] * v[1] + v[2] * v[2] + v[3] * v[3]; }
                    ss += __shfl_xor(ss, 16); ss += __shfl_xor(ss, 32);
                    const float rstd = rsqrtf(ss * (1.0f / 64.0f) + EPS);
#pragma unroll
                    for (int bj = 0; bj < 2; ++bj) {
                        f32x4 x1 = acc[ai][bj][m][0] * rstd * g4[bj][0];
                        f32x4 x2 = acc[ai][bj][m][1] * rstd * g4[bj][1];
                        {
                            const f32x4 cs0 = bj == 0 ? rc[ai][0] : ccur[0], cs1 = bj == 0 ? rc[ai][1] : ccur[1];
                            f32x4 cc = (f32x4){cs0[0], cs0[2], cs1[0], cs1[2]}, sn = (f32x4){cs0[1], cs0[3], cs1[1], cs1[3]};
                            if (!rp_on) { cc = (f32x4){1.f, 1.f, 1.f, 1.f}; sn = (f32x4){0.f, 0.f, 0.f, 0.f}; }
                            const f32x4 y1 = x1 * cc - x2 * sn, y2 = x2 * cc + x1 * sn;
                            x1 = y1; x2 = y2;
                        }
                        x1 = x1 * osc; x2 = x2 * osc;
                        o[bj][0].x = pk_bf16(x1[0], x1[1]); o[bj][0].y = pk_bf16(x1[2], x1[3]); o[bj][1].x = pk_bf16(x2[0], x2[1]); o[bj][1].y = pk_bf16(x2[2], x2[3]);
                    }
                }
#pragma unroll
                for (int bj = 0; bj < 2; ++bj)
#pragma unroll
                    for (int n = 0; n < 2; ++n) *(LAS u32x2*)(wp + (32 * bj + 16 * n) * 2) = o[bj][n];
                const u32x4 r0 = *(const LAS u32x4*)(rp), r1 = *(const LAS u32x4*)(rp + 16);
                bf16_t* dp = dbase + (size_t)(tl + rr) * rpitch + coff;
                *(u32x4*)(dp) = r0; *(u32x4*)(dp + 8) = r1;
            }
            ccur[0] = cnxt[0]; ccur[1] = cnxt[1];
        }
    }
};

__device__ __forceinline__ void phase_inproj(const Params& p, int l, unsigned char* smem) {
    const int kind = l % 3;
    InSched S; S.h = (const char*)p.h; S.wt = (const char*)sel4(p.wt_in, l); S.nK = kind == 0 ? 1 : 4; S.NU = 8 + 2 * S.nK; S.vrow = true;
    LAS float* ropeL = (LAS float*)((LAS unsigned char*)smem + 131072 + 18432);
    LAS float* gL = ropeL + 2048;
    {
        int tid = threadIdx.x; asm volatile("" : "+v"(tid));
        *(LAS f32x4*)(ropeL + tid * 4) = *(const f32x4*)(p.rope + tid * 4);
        if (tid < 64) gL[tid] = sel4(p.q_g, l)[tid]; else if (tid < 128) gL[tid] = sel4(p.k_g, l)[tid - 64];
        __syncthreads();
    }
    EpiIn E; E.ropeL = ropeL; E.gL = gL; E.q = p.q; E.k = p.k; E.vt = p.vt; E.sz = p.sz; E.nK = S.nK; E.do_rope = kind != 1; E.stg0 = (LAS unsigned char*)smem + 131072;
    pg8::gemm_phase(( LAS unsigned char*)smem, 1024, S, E);
}

struct OutSched {
    const char* og; const char* wt; int MT; bool ctxonly;
    __device__ __forceinline__ bool next(int i, pg8::Unit& u) const {
        int mt, un;
        if (ctxonly) { if (i > 0 || (blockIdx.x >> 3) >= 4) return false; mt = MLAT / 256 + (blockIdx.x & 7); un = blockIdx.x >> 3; }
        else if (!xcd_unit(i, MT, 4, mt, un)) return false;
        u.pm = mt; u.pn = un; u.kind = 0;
        u.a = og + (size_t)mt * 256 * D * 2; u.b = wt + (size_t)un * 256 * D * 2;
        return true;
    }
};
struct EpiOut {
    const float *x, *ctx, *mod; float *out, *xb; int l;
    __device__ __forceinline__ void operator()(const f32x4 (&acc)[2][2][4][2], const pg8::Unit& u, int wr, int wc, int fr, int fq) const {
        const int row0 = u.pm * 256;
        const bool isctx = row0 >= MLAT;
        const int bv = isctx ? 8 : (row0 >> 12);
        const int n0 = u.pn * 256 + wc * 32 + 4 * fq;
        const float* gtp = mod + ((size_t)l * 9 + bv) * 3072 + 2048 + n0;
        f32x4 g4[2][2];
#pragma unroll
        for (int bj = 0; bj < 2; ++bj)
#pragma unroll
            for (int n = 0; n < 2; ++n) g4[bj][n] = *(const f32x4*)(gtp + bj * 128 + n * 16);
        const float* src = l == 0 ? (isctx ? ctx + (size_t)(row0 - MLAT) * D : x + (size_t)row0 * D) : (isctx ? xb + (size_t)(row0 - MLAT) * D : out + (size_t)row0 * D);
        float* dstp = isctx ? xb + (size_t)(row0 - MLAT) * D : out + (size_t)row0 * D;
#pragma unroll
        for (int ai = 0; ai < 2; ++ai)
#pragma unroll
            for (int m = 0; m < 4; ++m) {
                const size_t ro = (size_t)(ai * 128 + wr * 64 + m * 16 + fr) * D + n0;
                f32x4 xv[2][2];
#pragma unroll
                for (int bj = 0; bj < 2; ++bj)
#pragma unroll
                    for (int n = 0; n < 2; ++n) xv[bj][n] = *(const f32x4*)(src + ro + bj * 128 + n * 16);
#pragma unroll
                for (int bj = 0; bj < 2; ++bj)
#pragma unroll
                    for (int n = 0; n < 2; ++n) *(f32x4*)(dstp + ro + bj * 128 + n * 16) = xv[bj][n] + g4[bj][n] * acc[ai][bj][m][n];
            }
    }
};

__device__ __forceinline__ void phase_outproj(const Params& p, int l, bool ctxonly, unsigned char* smem) {
    OutSched S; S.og = (const char*)p.og; S.wt = (const char*)sel4(p.wt_out, l); S.MT = MLAT / 256; S.ctxonly = ctxonly;
    EpiOut E; E.x = p.x; E.ctx = p.ctx; E.mod = p.mod; E.out = p.out; E.xb = p.xb; E.l = l;
    pg8::gemm_phase((LAS unsigned char*)smem, 1024, S, E);
}

namespace attn_a {
typedef unsigned short bf16;
using s16x4=__attribute__((ext_vector_type(4)))short;
constexpr int PQ=64;
constexpr int NW=8,QBLK=32,QB=QBLK*NW,KVBLK=64;
__device__ __forceinline__ int crow(int r,int hi){return (r&3)+8*(r>>2)+4*hi;}
#define SBAR() __builtin_amdgcn_sched_barrier(0)
__device__ __forceinline__ void cmask(f32x16&p0,f32x16&p1,int jb,int qrel,int hi){
  const float NEG=-INFINITY; int kb=64*jb+4*hi;
  #pragma unroll
  for(int r=0;r<16;++r){int kv=kb+(r&3)+8*(r>>2); if(kv>qrel)p0[r]=NEG; if(kv+32>qrel)p1[r]=NEG;}
}

constexpr int NSLOT=3, SLOTB=8192;
constexpr int LDS_K=0, LDS_V=NSLOT*SLOTB, LDS_WS=2*NSLOT*SLOTB, LDS_OST=LDS_WS+NW*64*4, LDS_BYTES=LDS_OST+NW*4096;
constexpr float C2=0.125f*1.4426950408889634f;
__device__ __forceinline__ void glds16(const void*gsrc,unsigned lds_dst){unsigned keep;
  asm volatile("s_mov_b32 %0, m0\n\ts_mov_b32 m0, %2\n\ts_nop 0\n\tglobal_load_lds_dwordx4 %1, off\n\ts_mov_b32 m0, %0":"=&s"(keep):"v"(gsrc),"s"(lds_dst):"memory");}
__device__ __forceinline__ float max3f(float a,float b,float c){float r;asm("v_max3_f32 %0, %1, %2, %3":"=v"(r):"v"(a),"v"(b),"v"(c));return r;}
__device__ __forceinline__ float max2f(float a,float b){float r;asm("v_max_f32_e32 %0, %1, %2":"=v"(r):"v"(a),"v"(b));return r;}
__device__ __forceinline__ float fadd_s(float a,float b){float r;asm("v_add_f32_e32 %0, %1, %2":"=v"(r):"v"(a),"v"(b));return r;}
__device__ __forceinline__ float fsub_s(float a,float b){float r;asm("v_sub_f32_e32 %0, %1, %2":"=v"(r):"v"(a),"v"(b));return r;}
typedef float f32x2_t __attribute__((ext_vector_type(2))); typedef __bf16 bf16x2_t __attribute__((ext_vector_type(2)));
__device__ __forceinline__ unsigned cvtpk_s(float lo,float hi){f32x2_t v={lo,hi};bf16x2_t b=__builtin_convertvector(v,bf16x2_t);return __builtin_bit_cast(unsigned,b);}
#define WAIT_BAR(N) asm volatile("s_waitcnt vmcnt(" #N ") lgkmcnt(0)\n\ts_barrier":::"memory")

__device__ __forceinline__ void qkt(f32x16&p0,f32x16&p1,const char*Kslot,const bf16x8*qr,const f32x16&negm,int r32,int hi){
  const char*kb=Kslot+hi*1024+r32*16;
  #pragma unroll
  for(int d0=0;d0<4;++d0){
    const bf16x8 b0=*reinterpret_cast<const bf16x8*>(kb+d0*2048);
    const bf16x8 b1=*reinterpret_cast<const bf16x8*>(kb+d0*2048+512);
    if(d0==0){p0=__builtin_amdgcn_mfma_f32_32x32x16_bf16(b0,qr[0],negm,0,0,0);p1=__builtin_amdgcn_mfma_f32_32x32x16_bf16(b1,qr[0],negm,0,0,0);}
    else{p0=__builtin_amdgcn_mfma_f32_32x32x16_bf16(b0,qr[d0],p0,0,0,0);p1=__builtin_amdgcn_mfma_f32_32x32x16_bf16(b1,qr[d0],p1,0,0,0);}}
}
typedef __attribute__((address_space(3))) const char* lds_cptr;
typedef short v4i16_t __attribute__((ext_vector_type(4)));
__device__ __forceinline__ void kload8(bf16x8*kf,lds_cptr kp){
  kf[0]=*(const __attribute__((address_space(3))) bf16x8*)(kp);      kf[1]=*(const __attribute__((address_space(3))) bf16x8*)(kp+512);
  kf[2]=*(const __attribute__((address_space(3))) bf16x8*)(kp+2048); kf[3]=*(const __attribute__((address_space(3))) bf16x8*)(kp+2560);
  kf[4]=*(const __attribute__((address_space(3))) bf16x8*)(kp+4096); kf[5]=*(const __attribute__((address_space(3))) bf16x8*)(kp+4608);
  kf[6]=*(const __attribute__((address_space(3))) bf16x8*)(kp+6144); kf[7]=*(const __attribute__((address_space(3))) bf16x8*)(kp+6656);
}
__device__ __forceinline__ void kload2(bf16x8*kf,lds_cptr kp,int j){ kf[2*j]=*(const __attribute__((address_space(3))) bf16x8*)(kp+j*2048); kf[2*j+1]=*(const __attribute__((address_space(3))) bf16x8*)(kp+j*2048+512); }
__device__ __forceinline__ s16x4 vtr(lds_cptr p){ return __builtin_bit_cast(s16x4,__builtin_amdgcn_ds_read_tr16_b64_v4i16((__attribute__((address_space(3))) v4i16_t*)p)); }
__device__ __forceinline__ float rowmax(const f32x16&p0,const f32x16&p1){
  float a=max3f(p0[0],p0[1],p1[0]),b=max3f(p0[2],p0[3],p1[1]);a=max3f(a,p1[2],p1[3]);
  #pragma unroll
  for(int r=4;r<16;r+=4){a=max3f(a,p0[r],p0[r+1]);b=max3f(b,p0[r+2],p0[r+3]);a=max3f(a,p1[r],p1[r+1]);b=max3f(b,p1[r+2],p1[r+3]);}
  const float m=max2f(a,b);
  auto rr=__builtin_amdgcn_permlane32_swap(__float_as_uint(m),__float_as_uint(m),false,false);
  return max2f(__uint_as_float(rr[0]),__uint_as_float(rr[1]));
}
__device__ __forceinline__ void pv(f32x16*o,int vb,bf16x8 pa0,bf16x8 pa1,bf16x8 pa2,bf16x8 pa3){
  #pragma unroll
  for(int d0=0;d0<2;++d0){s16x4 lo[4],hi[4];
    #pragma unroll
    for(int ks=0;ks<4;++ks){
      asm volatile("ds_read_b64_tr_b16 %0,%1 offset:%c2":"=&v"(lo[ks]):"v"(vb),"i"(d0*4096+ks*1024):"memory");
      asm volatile("ds_read_b64_tr_b16 %0,%1 offset:%c2":"=&v"(hi[ks]):"v"(vb),"i"(d0*4096+ks*1024+512):"memory");}
    asm volatile("s_waitcnt lgkmcnt(0)":::"memory");SBAR();
    #define PK(k) (bf16x8){lo[k][0],lo[k][1],lo[k][2],lo[k][3],hi[k][0],hi[k][1],hi[k][2],hi[k][3]}
    o[d0]=__builtin_amdgcn_mfma_f32_32x32x16_bf16(pa0,PK(0),o[d0],0,0,0);
    o[d0]=__builtin_amdgcn_mfma_f32_32x32x16_bf16(pa1,PK(1),o[d0],0,0,0);
    o[d0]=__builtin_amdgcn_mfma_f32_32x32x16_bf16(pa2,PK(2),o[d0],0,0,0);
    o[d0]=__builtin_amdgcn_mfma_f32_32x32x16_bf16(pa3,PK(3),o[d0],0,0,0);
    #undef PK
  }
}

template<int THRL,bool NBRM=false,bool DV2=false> __device__ __forceinline__ void attn_unit(const bf16*Qu,const bf16*__restrict__ Kh,const bf16*__restrict__ Vh,const int NT,const bf16*SZu,bf16*OGu,char*shm,
                                                                      const int rowoff=0,const int qrow0=0,const LAS float*rpbL=nullptr,const bf16*__restrict__ V2h=nullptr,float*Oraw=nullptr){
  constexpr int LDS_V2=LDS_BYTES, ND=DV2?4:2;
  #define WB(a,b) do{ if constexpr(DV2){WAIT_BAR(b);} else {WAIT_BAR(a);} }while(0)
  int tid=threadIdx.x; asm volatile("":"+v"(tid)); const int lane=tid&63,r32=lane&31,hi=lane>>5; const int wid=__builtin_amdgcn_readfirstlane(tid>>6);
  const bf16*Qw=Qu+(long)wid*QBLK*PQ;
  const unsigned lds0=(unsigned)(uintptr_t)shm;
  float*wsf=(float*)(shm+LDS_WS)+wid*64;
  const bf16*ksrc=Kh+(long)lane*PQ+wid*8;
  const bf16*vsrc=Vh+(long)(16*(wid&3)+(lane>>2))*PQ+(wid>>2)*32+(lane&3)*8;
  const unsigned kdst=lds0+LDS_K+wid*1024, vdst=lds0+LDS_V+wid*1024;
  #define TMAP(t) ((NBRM&&(t)>=4)?((t)+rowoff):(t))
  #define DMA_K(t,slot) glds16(ksrc+(long)TMAP(t)*KVBLK*PQ,(unsigned)__builtin_amdgcn_readfirstlane(kdst+(slot)))
  #define DMA_V(t,slot) glds16(vsrc+(long)TMAP(t)*KVBLK*PQ,(unsigned)__builtin_amdgcn_readfirstlane(vdst+(slot)))
  const bf16*v2src=DV2?V2h+(vsrc-Vh):vsrc; const unsigned v2dst=lds0+LDS_V2+wid*1024;
  #define DMA_V2(t,slot) do{ if constexpr(DV2) glds16(v2src+(long)TMAP(t)*KVBLK*PQ,(unsigned)__builtin_amdgcn_readfirstlane(v2dst+(slot))); }while(0)
  const int vb0=(int)(lds0+LDS_V)+((lane>>4)&1)*32+(lane&3)*8+(4*hi+((lane&15)>>2))*64;
  const char*Kbase=shm+LDS_K; bf16x8 kf[8];
  const lds_cptr shm3=(lds_cptr)shm; const lds_cptr kp0=shm3+LDS_K+hi*1024+r32*16; const lds_cptr vp0=shm3+LDS_V+((lane>>4)&1)*32+(lane&3)*8+(4*hi+((lane&15)>>2))*64;
  DMA_K(0,0);DMA_V(0,0);DMA_V2(0,0);DMA_K(1,SLOTB);
  bf16x8 qr[4];
  #pragma unroll
  for(int d0=0;d0<4;++d0)qr[d0]=*reinterpret_cast<const bf16x8*>(&Qw[(long)r32*PQ+d0*16+hi*8]);
  float mhat=0.f,l_reg=0.f;f32x16 o[ND];
  #pragma unroll
  for(int d_=0;d_<ND;++d_)o[d_]=f32x16{};
  f32x16 negm=f32x16{}; if constexpr(!DV2) asm volatile("":"+v"(negm));
  const f32x16 zero16=f32x16{};
  #define NEGM (DV2?zero16:negm)
  const int nq_r=qrow0+(wid>>1), nq_c=(wid&1)*32+r32, n_rsw=min(max(nq_r-4,0),56), n_cs=min(max(nq_c-8,0),48);
  #define CMASK(P0,P1,t) do{ if constexpr(NBRM){ const int t_=(t); if(t_>=4){ const int kr_=rowoff+t_-4; \
      if((unsigned)(kr_-n_rsw)>=8u){ _Pragma("unroll") for(int r=0;r<16;++r){P0[r]=-INFINITY;P1[r]=-INFINITY;} } \
      else{ const LAS float*bp_=rpbL+(kr_-nq_r+7)*31+15-nq_c; \
        _Pragma("unroll") for(int r=0;r<16;++r){ const int kc_=crow(r,hi); \
          const bool v0_=(unsigned)(kc_-n_cs)<16u, v1_=(unsigned)(kc_+32-n_cs)<16u; \
          const float b0_=v0_?bp_[kc_]:0.f, b1_=v1_?bp_[kc_+32]:0.f; \
          P0[r]=v0_?P0[r]+b0_:-INFINITY; P1[r]=v1_?P1[r]+b1_:-INFINITY; } } } } }while(0)
  bool resc=false;
  #define START(P0,P1) do{ const float rm=rowmax(P0,P1); resc=false; \
    { const float dl=rm; mhat=fadd_s(mhat,dl); \
      _Pragma("unroll") for(int r=0;r<16;++r){P0[r]=fsub_s(P0[r],dl);P1[r]=fsub_s(P1[r],dl);} \
      if constexpr(!DV2){ _Pragma("unroll") for(int r=0;r<16;++r)negm[r]=-mhat; asm volatile("":"+v"(negm)); } } \
    _Pragma("unroll") for(int r=0;r<16;++r)P0[r]=__builtin_amdgcn_exp2f(P0[r]); }while(0)
  #define RESC() do{ if(resc){ asm volatile("s_waitcnt lgkmcnt(0)":::"memory"); \
      _Pragma("unroll") for(int d_=0;d_<ND;++d_) _Pragma("unroll") for(int r=0;r<16;++r)o[d_][r]*=wsf[crow(r,hi)]; } }while(0)
  f32x16 pA0,pA1,pB0,pB1;
  int sl_prev=0,sl_cur=0,sl_next=SLOTB;
  #define ROT() do{sl_prev=sl_cur;sl_cur=sl_next;sl_next=(sl_next==(NSLOT-1)*SLOTB)?0:sl_next+SLOTB;}while(0)
  DMA_K(2,2*SLOTB);
  WB(3,4);
  qkt(pA0,pA1,Kbase,qr,NEGM,r32,hi);asm volatile("s_nop 15\n\ts_nop 7":"+v"(pA0),"+v"(pA1));CMASK(pA0,pA1,0);
  START(pA0,pA1);
  _Pragma("unroll") for(int r=0;r<16;++r)pA1[r]=__builtin_amdgcn_exp2f(pA1[r]);
  WAIT_BAR(0);
  DMA_K(3,0);DMA_V(1,SLOTB);DMA_V2(1,SLOTB);
  ROT();
  kload8(kf,kp0+sl_cur);
  WB(2,3);
  s16x4 vlo[8],vhi[8]; u32x4 pw0,pw1,pw2,pw3;
  #define PKW(P,B) cvtpk_s(P[B],P[B+1])
  #define PAF(k) __builtin_bit_cast(bf16x8,pw##k)
  #define VFR(i) (bf16x8){vlo[i][0],vlo[i][1],vlo[i][2],vlo[i][3],vhi[i][0],vhi[i][1],vhi[i][2],vhi[i][3]}
  #define PIN(x) asm volatile("":"+v"(x))
  #define MX3(a,b,c) __builtin_fmaxf(__builtin_fmaxf((a),(b)),(c))
  #define GAPA(MF,A0,A1,A2,A3,W0,W1,PW) do{ MF; sacc+=A0; sacc+=A1; sacc+=A2; sacc+=A3; PIN(sacc); W0; W1; PIN(PW); SBAR(); }while(0)
  #define EX(v) (DV2?__builtin_amdgcn_exp2f((v)-mhat):__builtin_amdgcn_exp2f(v))
  #define GAPB(MF,X,B) do{ MF; X[B]=EX(X[B]); X[B+1]=EX(X[B+1]); X[B+2]=EX(X[B+2]); X[B+3]=EX(X[B+3]); PIN(X); SBAR(); }while(0)
  #define GAPH(MF,X,B) do{ MF; X[B]=EX(X[B]); X[B+1]=EX(X[B+1]); PIN(X); SBAR(); }while(0)
  #define GAPX(MF,XA,BA,XH,BH) do{ if constexpr(DV2){ GAPH(MF,XH,BH); } else { GAPB(MF,XA,BA); } }while(0)
  #define VRD(i) do{ vlo[i]=vtr(vp_+(((i)>>2)*4096+((i)&3)*1024)); vhi[i]=vtr(vp_+(((i)>>2)*4096+((i)&3)*1024+512)); }while(0)
  #define KRD(G,j) do{ if(G){ kload2(kf,kp0+sl_next,j); SBAR(); } }while(0)
  #define KRD1(G,j) do{ if constexpr(!DV2){ KRD(G,j); } }while(0)
  #define V2R(i) do{ if constexpr(DV2){ vlo[i]=vtr(vq_+(((i)>>2)*4096+((i)&3)*1024)); vhi[i]=vtr(vq_+(((i)>>2)*4096+((i)&3)*1024+512)); SBAR(); } }while(0)
  #define STEP(C0,C1,P0,P1,t,GK,GV,GL) do{ SBAR(); \
    const lds_cptr vp_=vp0+sl_prev; const lds_cptr vq_=vp0+(LDS_V2-LDS_V)+sl_prev; (void)vq_; \
    VRD(0); SBAR(); float sacc=(P0[0]+P0[1]); \
    GAPA(C0=__builtin_amdgcn_mfma_f32_32x32x16_bf16(kf[0],qr[0],NEGM,0,0,0), P0[2],P0[3],P0[4],P0[5],     pw0[0]=PKW(P0,0), pw0[1]=PKW(P0,2), pw0); \
    VRD(4); SBAR(); GAPA(C1=__builtin_amdgcn_mfma_f32_32x32x16_bf16(kf[1],qr[0],NEGM,0,0,0), P0[6],P0[7],P0[8],P0[9],     pw0[2]=PKW(P0,4), pw0[3]=PKW(P0,6), pw0); \
    VRD(1); SBAR(); GAPA(C0=__builtin_amdgcn_mfma_f32_32x32x16_bf16(kf[2],qr[1],C0,0,0,0),   P0[10],P0[11],P0[12],P0[13], pw1[0]=PKW(P0,8), pw1[1]=PKW(P0,10), pw1); \
    VRD(5); SBAR(); GAPA(C1=__builtin_amdgcn_mfma_f32_32x32x16_bf16(kf[3],qr[1],C1,0,0,0),   P0[14],P0[15],P1[0],P1[1],   pw1[2]=PKW(P0,12),pw1[3]=PKW(P0,14), pw1); \
    VRD(2); SBAR(); GAPA(C0=__builtin_amdgcn_mfma_f32_32x32x16_bf16(kf[4],qr[2],C0,0,0,0),   P1[2],P1[3],P1[4],P1[5],     pw2[0]=PKW(P1,0), pw2[1]=PKW(P1,2), pw2); \
    VRD(6); SBAR(); GAPA(C1=__builtin_amdgcn_mfma_f32_32x32x16_bf16(kf[5],qr[2],C1,0,0,0),   P1[6],P1[7],P1[8],P1[9],     pw2[2]=PKW(P1,4), pw2[3]=PKW(P1,6), pw2); \
    VRD(3); SBAR(); GAPA(C0=__builtin_amdgcn_mfma_f32_32x32x16_bf16(kf[6],qr[3],C0,0,0,0),   P1[10],P1[11],P1[12],P1[13], pw3[0]=PKW(P1,8), pw3[1]=PKW(P1,10), pw3); \
    VRD(7); SBAR(); GAPA(C1=__builtin_amdgcn_mfma_f32_32x32x16_bf16(kf[7],qr[3],C1,0,0,0),   P1[14],P1[15],0.f,0.f,       pw3[2]=PKW(P1,12),pw3[3]=PKW(P1,14), pw3); \
    l_reg+=sacc; \
    if(GK){DMA_K((t)+3,sl_cur);} if(GV){DMA_V((t)+1,sl_next);DMA_V2((t)+1,sl_next);} \
    CMASK(C0,C1,t); \
    { float a=MX3(C0[0],C0[1],C1[0]),b=MX3(C0[2],C0[3],C1[1]); a=MX3(a,C1[2],C1[3]); \
      _Pragma("unroll") for(int r=4;r<16;r+=4){a=MX3(a,C0[r],C0[r+1]);b=MX3(b,C0[r+2],C0[r+3]);a=MX3(a,C1[r],C1[r+1]);b=MX3(b,C1[r+2],C1[r+3]);} \
      float rm=__builtin_fmaxf(a,b); { auto rr=__builtin_amdgcn_permlane32_swap(__float_as_uint(rm),__float_as_uint(rm),false,false); rm=__builtin_fmaxf(__uint_as_float(rr[0]),__uint_as_float(rr[1])); } \
      if constexpr(DV2) rm-=mhat; \
      resc=false; \
      if(__builtin_expect(__any(rm>(float)THRL),0)){ const float dl=__builtin_fmaxf(rm,0.f); mhat+=dl; \
        if constexpr(!DV2){ _Pragma("unroll") for(int r=0;r<16;++r){C0[r]-=dl;C1[r]-=dl;} } \
        if constexpr(!DV2){ _Pragma("unroll") for(int r=0;r<16;++r)negm[r]=-mhat; asm volatile("":"+v"(negm)); } \
        const float f=__builtin_amdgcn_exp2f(-dl); l_reg*=f; if(hi==0)wsf[r32]=f; resc=true; } } \
    SBAR(); \
    GAPX(o[0]=__builtin_amdgcn_mfma_f32_32x32x16_bf16(PAF(0),VFR(0),o[0],0,0,0), C0,0,  C0,0); V2R(0); \
    GAPX(o[1]=__builtin_amdgcn_mfma_f32_32x32x16_bf16(PAF(0),VFR(4),o[1],0,0,0), C0,4,  C0,2); V2R(4); \
    KRD1(GL,0); GAPX(o[0]=__builtin_amdgcn_mfma_f32_32x32x16_bf16(PAF(1),VFR(1),o[0],0,0,0), C0,8,  C0,4); V2R(1); \
    KRD1(GL,1); GAPX(o[1]=__builtin_amdgcn_mfma_f32_32x32x16_bf16(PAF(1),VFR(5),o[1],0,0,0), C0,12, C0,6); V2R(5); \
    KRD1(GL,2); GAPX(o[0]=__builtin_amdgcn_mfma_f32_32x32x16_bf16(PAF(2),VFR(2),o[0],0,0,0), C1,0,  C0,8); V2R(2); \
    KRD1(GL,3); GAPX(o[1]=__builtin_amdgcn_mfma_f32_32x32x16_bf16(PAF(2),VFR(6),o[1],0,0,0), C1,4,  C0,10); V2R(6); \
    GAPX(o[0]=__builtin_amdgcn_mfma_f32_32x32x16_bf16(PAF(3),VFR(3),o[0],0,0,0), C1,8,  C0,12); V2R(3); \
    GAPX(o[1]=__builtin_amdgcn_mfma_f32_32x32x16_bf16(PAF(3),VFR(7),o[1],0,0,0), C1,12, C0,14); V2R(7); \
    if constexpr(DV2){ \
      GAPH(o[ND-2]=__builtin_amdgcn_mfma_f32_32x32x16_bf16(PAF(0),VFR(0),o[ND-2],0,0,0), C1,0); \
      GAPH(o[ND-1]=__builtin_amdgcn_mfma_f32_32x32x16_bf16(PAF(0),VFR(4),o[ND-1],0,0,0), C1,2); \
      KRD(GL,0); GAPH(o[ND-2]=__builtin_amdgcn_mfma_f32_32x32x16_bf16(PAF(1),VFR(1),o[ND-2],0,0,0), C1,4); \
      KRD(GL,1); GAPH(o[ND-1]=__builtin_amdgcn_mfma_f32_32x32x16_bf16(PAF(1),VFR(5),o[ND-1],0,0,0), C1,6); \
      KRD(GL,2); GAPH(o[ND-2]=__builtin_amdgcn_mfma_f32_32x32x16_bf16(PAF(2),VFR(2),o[ND-2],0,0,0), C1,8); \
      KRD(GL,3); GAPH(o[ND-1]=__builtin_amdgcn_mfma_f32_32x32x16_bf16(PAF(2),VFR(6),o[ND-1],0,0,0), C1,10); \
      GAPH(o[ND-2]=__builtin_amdgcn_mfma_f32_32x32x16_bf16(PAF(3),VFR(3),o[ND-2],0,0,0), C1,12); \
      GAPH(o[ND-1]=__builtin_amdgcn_mfma_f32_32x32x16_bf16(PAF(3),VFR(7),o[ND-1],0,0,0), C1,14); } \
    }while(0)
  int t=1;
  for(;t+5<NT;t+=2){
    STEP(pB0,pB1,pA0,pA1,t,true,true,true);     WB(2,3); RESC(); ROT();
    STEP(pA0,pA1,pB0,pB1,t+1,true,true,true);   WB(2,3); RESC(); ROT();
  }
  #define ENDW(tt) do{ if((tt)+3<NT){WB(2,3);} else if((tt)+2<NT){WB(1,2);} else {WAIT_BAR(0);} }while(0)
  for(;t+1<NT;t+=2){
    STEP(pB0,pB1,pA0,pA1,t,(t+3<NT),(t+1<NT),(t+1<NT));       ENDW(t);   RESC(); ROT();
    STEP(pA0,pA1,pB0,pB1,t+1,(t+4<NT),(t+2<NT),(t+2<NT));     ENDW(t+1); RESC(); ROT();
  }
  STEP(pB0,pB1,pA0,pA1,NT-1,false,false,false); RESC();
  { float sacc=pB0[0]+pB0[1]; _Pragma("unroll") for(int r=2;r<16;++r)sacc+=pB0[r]; _Pragma("unroll") for(int r=0;r<16;++r)sacc+=pB1[r]; l_reg+=sacc;
    pw0=(u32x4){PKW(pB0,0),PKW(pB0,2),PKW(pB0,4),PKW(pB0,6)};pw1=(u32x4){PKW(pB0,8),PKW(pB0,10),PKW(pB0,12),PKW(pB0,14)};pw2=(u32x4){PKW(pB1,0),PKW(pB1,2),PKW(pB1,4),PKW(pB1,6)};pw3=(u32x4){PKW(pB1,8),PKW(pB1,10),PKW(pB1,12),PKW(pB1,14)};
    SBAR(); pv(o,vb0+sl_cur,PAF(0),PAF(1),PAF(2),PAF(3)); if constexpr(DV2) pv(o+2,vb0+(LDS_V2-LDS_V)+sl_cur,PAF(0),PAF(1),PAF(2),PAF(3)); }
  #undef PKW
  #undef PAF
  #undef VFR
  #undef PIN
  #undef MX3
  #undef GAPA
  #undef GAPB
  #undef GAPH
  #undef GAPX
  #undef EX
  #undef VRD
  #undef KRD
  #undef KRD1
  #undef V2R
  #undef STEP
  #undef ENDW
  {auto rr=__builtin_amdgcn_permlane32_swap(__float_as_uint(l_reg),__float_as_uint(l_reg),false,false);l_reg=__uint_as_float(rr[0])+__uint_as_float(rr[1]);}
  if(hi==0)wsf[32+r32]=l_reg;asm volatile("s_waitcnt lgkmcnt(0)":::"memory");
  float rli[16];
  #pragma unroll
  for(int r=0;r<16;++r)rli[r]=__builtin_amdgcn_rcpf(wsf[32+crow(r,hi)]);
  if constexpr(DV2){ float*Orw=Oraw+(long)wid*QBLK*128;
    #pragma unroll
    for(int r=0;r<16;++r){const int orow=crow(r,hi);
      #pragma unroll
      for(int d0=0;d0<4;++d0) Orw[orow*128+d0*32+r32]=o[d0][r]*rli[r];}
  } else {
  bf16*Ow=OGu+(long)wid*QBLK*1024; const bf16*Zw=SZu+(long)wid*QBLK*1024;
  { bf16*stg=(bf16*)(shm+LDS_OST)+wid*2048;
    #pragma unroll
    for(int r=0;r<16;++r){const int orow=crow(r,hi);
      #pragma unroll
      for(int d0=0;d0<2;++d0) stg[orow*64+d0*32+r32]=(bf16)(pk_bf16(o[d0][r]*rli[r],0.f)&0xffffu);}
    asm volatile("s_waitcnt lgkmcnt(0)":::"memory");
    #pragma unroll
    for(int i=0;i<4;++i){const int row=i*8+(lane>>3),ch=lane&7; const u32x4 v=*(const u32x4*)(stg+row*64+ch*8); const u32x4 z=*(const u32x4*)(Zw+(long)row*1024+ch*8); u32x4 g;
      #pragma unroll
      for(int e=0;e<4;++e){ const float a0=__uint_as_float(v[e]<<16)*__uint_as_float(z[e]<<16), a1=__uint_as_float(v[e]&0xffff0000u)*__uint_as_float(z[e]&0xffff0000u); g[e]=pk_bf16(a0,a1); }
      *(u32x4*)(Ow+(long)row*1024+ch*8)=g;} }
  }
  asm volatile("s_waitcnt lgkmcnt(0)\n\ts_barrier":::"memory");
  #undef DMA_K
  #undef DMA_V2
  #undef NEGM
  #undef WB
  #undef TMAP
  #undef DMA_V
  #undef CMASK
  #undef START
  #undef RESC
  #undef ROT
}
#undef SBAR
#undef WAIT_BAR
}

constexpr int ATT_BUF = 64 * LDT + 128 * LDT;
template <int NDB, bool NBR>
__device__ __forceinline__ void attn_pass(const int tid, const bf16_t* __restrict__ Qrow, const bf16_t* __restrict__ Kb, const bf16_t* __restrict__ Vb,
                                          int ntiles, int rs0, int qr, int qc, int rsw, const float* srpb,
                                          bf16_t* sbase, f32x16 (&O)[NDB], float& lsum_out) {
    const int lane = tid & 63, lr = lane & 31, lh = lane >> 5;
    const int lrow = tid >> 3, lpart = tid & 7;
    constexpr int NV = NDB / 2;
    bf16x8 qf[4];
#pragma unroll
    for (int s = 0; s < 4; ++s) qf[s] = *(const bf16x8*)(Qrow + s * 16);
#pragma unroll
    for (int db = 0; db < NDB; ++db)
#pragma unroll
        for (int i = 0; i < 16; ++i) O[db][i] = 0.f;
    float m = -1e30f, lsum = 0.f;
    u32x4 kreg, vreg[NV];
    auto key0_of = [&](int it) -> int { return (NBR && it >= 4) ? (CTXL + (rs0 + it - 4) * 64) : it * 64; };
    auto gload = [&](int it) {
        const int key0 = key0_of(it);
        kreg = *(const u32x4*)(Kb + (size_t)(key0 + lrow) * 64 + lpart * 8);
#pragma unroll
        for (int j = 0; j < NV; ++j) vreg[j] = *(const u32x4*)(Vb + (size_t)(lrow + 64 * j) * TT + key0 + lpart * 8);
    };
    auto swrite = [&](int buf) {
        bf16_t* sb = sbase + buf * ATT_BUF;
        *(u32x4*)(sb + lrow * LDT + lpart * 8) = kreg;
#pragma unroll
        for (int j = 0; j < NV; ++j) *(u32x4*)(sb + 64 * LDT + (lrow + 64 * j) * LDT + lpart * 8) = vreg[j];
    };
    gload(0);
    __syncthreads();
    swrite(0);
    if (ntiles > 1) gload(1);
    __syncthreads();
    const int kfo = swap23(lr) * LDT + lh * 8;
    const int vfo = 64 * LDT + lr * LDT + lh * 8;
    const int cs_ = min(max(qc - 8, 0), 48);
#pragma unroll 1
    for (int it = 0; it < ntiles; ++it) {
        if (it + 1 < ntiles) swrite((it + 1) & 1);
        if (it + 2 < ntiles) gload(it + 2);
        const bf16_t* sb = sbase + (it & 1) * ATT_BUF;
        const int kr = rs0 + it - 4;
        const bool act = !NBR || it < 4 || (kr >= rsw && kr < rsw + 8);
        if (act) {
            f32x16 S[2];
#pragma unroll
            for (int sub = 0; sub < 2; ++sub) {
#pragma unroll
                for (int i = 0; i < 16; ++i) S[sub][i] = 0.f;
#pragma unroll
                for (int s = 0; s < 4; ++s) {
                    const bf16x8 kf = *(const bf16x8*)(sb + kfo + sub * 32 * LDT + s * 16);
                    S[sub] = MFMA32(kf, qf[s], S[sub]);
                }
            }
            if (NBR && it >= 4) {
                const float* bp = srpb + (kr - qr + 7) * 31 + 15 - qc;
#pragma unroll
                for (int sub = 0; sub < 2; ++sub)
#pragma unroll
                    for (int i = 0; i < 16; ++i) {
                        const int kc = sub * 32 + (i & 7) + 8 * lh + 16 * (i >> 3);
                        const bool valid = (unsigned)(kc - cs_) < 16u;
                        const float bias = valid ? bp[kc] : 0.f;
                        S[sub][i] = valid ? S[sub][i] + bias : -1e30f;
                    }
            }
            float mx = S[0][0];
#pragma unroll
            for (int i = 1; i < 16; ++i) mx = fmaxf(mx, S[0][i]);
#pragma unroll
            for (int i = 0; i < 16; ++i) mx = fmaxf(mx, S[1][i]);
            mx = fmaxf(mx, __shfl_xor(mx, 32));
            const bool need = mx > m;
            {
                const float mnew = need ? mx : m;
                const float alpha = fast_exp2(m - mnew);
                m = mnew;
                lsum *= alpha;
#pragma unroll
                for (int db = 0; db < NDB; ++db)
#pragma unroll
                    for (int i = 0; i < 16; ++i) O[db][i] *= alpha;
            }
            float rs = 0.f;
#pragma unroll
            for (int sub = 0; sub < 2; ++sub)
#pragma unroll
                for (int i = 0; i < 16; ++i) { const float pv = fast_exp2(S[sub][i] - m); S[sub][i] = pv; rs += pv; }
            lsum += rs;
#pragma unroll
            for (int sub = 0; sub < 2; ++sub)
#pragma unroll
                for (int s2 = 0; s2 < 2; ++s2) {
                    u32x4 pw;
                    pw.x = pk_bf16(S[sub][8 * s2 + 0], S[sub][8 * s2 + 1]); pw.y = pk_bf16(S[sub][8 * s2 + 2], S[sub][8 * s2 + 3]);
                    pw.z = pk_bf16(S[sub][8 * s2 + 4], S[sub][8 * s2 + 5]); pw.w = pk_bf16(S[sub][8 * s2 + 6], S[sub][8 * s2 + 7]);
                    const bf16x8 pf = __builtin_bit_cast(bf16x8, pw);
#pragma unroll
                    for (int db = 0; db < NDB; ++db) {
                        const bf16x8 vf = *(const bf16x8*)(sb + vfo + db * 32 * LDT + (sub * 2 + s2) * 16);
                        O[db] = MFMA32(vf, pf, O[db]);
                    }
                }
        }
        __syncthreads();
    }
    lsum_out = lsum + __shfl_xor(lsum, 32);
}

template <int NDB>
__device__ __forceinline__ void attn_store(const Params& p, int row, int col0, const f32x16 (&O)[NDB], int lh) {
    const bf16_t* szr = p.sz + (size_t)row * D + col0;
    bf16_t* ogr = p.og + (size_t)row * D + col0;
#pragma unroll
    for (int db = 0; db < NDB; ++db)
#pragma unroll
        for (int g4 = 0; g4 < 4; ++g4) {
            const int d0 = db * 32 + 8 * g4 + 4 * lh;
            const u32x2 zz = *(const u32x2*)(szr + d0);
            const float z0 = __uint_as_float(zz.x << 16), z1 = __uint_as_float(zz.x & 0xffff0000u);
            const float z2 = __uint_as_float(zz.y << 16), z3 = __uint_as_float(zz.y & 0xffff0000u);
            u32x2 o; o.x = pk_bf16(O[db][4 * g4 + 0] * z0, O[db][4 * g4 + 1] * z1); o.y = pk_bf16(O[db][4 * g4 + 2] * z2, O[db][4 * g4 + 3] * z3);
            *(u32x2*)(ogr + d0) = o;
        }
}

__device__ __forceinline__ void phase_attn(const Params& p, int l, unsigned char* smem) {
    const int kind = l % 3;
    const bool need_ctx = l < 3;
    bf16_t* sbase = (bf16_t*)smem; float* srpb = (float*)(sbase + 2 * ATT_BUF);
    int tid = threadIdx.x; asm volatile("" : "+v"(tid));
    const int lane = tid & 63, w = tid >> 6, lr = lane & 31, lh = lane >> 5;
    const int b = blockIdx.x & 7, xj = blockIdx.x >> 3, xn = gridDim.x >> 3;
    if (kind == 0) {
        const int nlat = 16 * 16, nctx = need_ctx ? 16 : 0;
        for (int li = xj; li < nlat + nctx; li += xn) {
            int head, qb; const bool isctx = li >= nlat;
            if (!isctx) { qb = li & 15; head = li >> 4; } else { qb = 0; head = li - nlat; }
            const int kh = head >> 2;
            const bf16_t* Qu = p.q + (((size_t)b * 16 + head) * TT + (isctx ? 0 : CTXL + qb * 256)) * 64;
            const bf16_t* Kh = p.k + ((size_t)b * 4 + kh) * TT * 64;
            const bf16_t* Vh = p.vt + ((size_t)b * 4 + kh) * TT * 64;
            const size_t grow0 = isctx ? (size_t)MLAT + b * CTXL : (size_t)b * SEQ + qb * 256;
            attn_a::attn_unit<8>(Qu, Kh, Vh, isctx ? 4 : TT / 64, p.sz + grow0 * D + head * 64, p.og + grow0 * D + head * 64, (char*)smem);
        }
    } else if (kind == 1) {
        const int nlat = 16 * 16, nctx = need_ctx ? 16 : 0;
        LAS float* rpbL = (LAS float*)((LAS unsigned char*)smem + 90112);
        for (int li = xj; li < nlat + nctx; li += xn) {
            int head, qb; const bool isctx = li >= nlat;
            if (!isctx) { qb = li & 15; head = li >> 4; } else { qb = 0; head = li - nlat; }
            const bf16_t* Qu = p.q + (((size_t)b * 16 + head) * TT + (isctx ? 0 : CTXL + qb * 256)) * 64;
            const bf16_t* Kh = p.k + ((size_t)b * 16 + head) * TT * 64;
            const bf16_t* Vh = p.vt + ((size_t)b * 16 + head) * TT * 64;
            const size_t grow0 = isctx ? (size_t)MLAT + b * CTXL : (size_t)b * SEQ + qb * 256;
            if (!isctx) {
                const int rstart = min(min(max(4 * qb - 4, 0), 56), 52);
                for (int idx = tid; idx < 465; idx += NTHR) rpbL[idx] = p.rpb[head * 465 + idx] * LOG2E;
                attn_a::attn_unit<8, true>(Qu, Kh, Vh, 16, p.sz + grow0 * D + head * 64, p.og + grow0 * D + head * 64, (char*)smem, rstart, 4 * qb, rpbL);
            } else {
                attn_a::attn_unit<8, false>(Qu, Kh, Vh, 4, p.sz + grow0 * D + head * 64, p.og + grow0 * D + head * 64, (char*)smem);
            }
        }
    } else {
        const float lam = p.lam[0];
        const float post = 1.0f - p.lam_init;
        float* blk = p.scr + (size_t)blockIdx.x * (2 * 256 * 128);
        const int nlat = 8 * 16, nctx = need_ctx ? 8 : 0;
        for (int li = xj; li < nlat + nctx; li += xn) {
            int hh, qb; const bool isctx = li >= nlat;
            if (!isctx) { qb = li & 15; hh = li >> 4; } else { qb = 0; hh = li - nlat; }
            const int qpos0 = isctx ? 0 : CTXL + qb * 256;
            const size_t grow0 = isctx ? (size_t)MLAT + b * CTXL : (size_t)b * SEQ + qb * 256;
            const int nt = isctx ? 4 : TT / 64;
            const bf16_t* Va = p.vt + ((size_t)b * 16 + hh * 2) * TT * 64;
            const bf16_t* Vb = p.vt + ((size_t)b * 16 + hh * 2 + 1) * TT * 64;
#pragma unroll 1
            for (int mm = 0; mm < 2; ++mm) {
                const bf16_t* Qu = p.q + (((size_t)b * 16 + hh * 2 + mm) * TT + qpos0) * 64;
                const bf16_t* Kh = p.k + ((size_t)b * 16 + hh * 2 + mm) * TT * 64;
                attn_a::attn_unit<8, false, true>(Qu, Kh, Va, nt, nullptr, nullptr, (char*)smem, 0, 0, nullptr, Vb, blk + mm * (256 * 128));
            }
            __syncthreads();
            const float g0 = p.subln_g[lane * 2], g1 = p.subln_g[lane * 2 + 1];
#pragma unroll 8
            for (int i = 0; i < 32; ++i) {
                const int qrow = w * 32 + i;
                const float2 a0 = *(const float2*)(blk + (size_t)qrow * 128 + lane * 2);
                const float2 a1 = *(const float2*)(blk + (size_t)(256 + qrow) * 128 + lane * 2);
                const unsigned zz = *(const unsigned*)(p.sz + (grow0 + qrow) * D + hh * 128 + lane * 2);
                const float o0 = a0.x - lam * a1.x, o1 = a0.y - lam * a1.y;
                float ss = o0 * o0 + o1 * o1;
                ss = wave_sum64(ss);
                const float rstd = rsqrtf(ss * (1.0f / 128.0f) + EPS) * post;
                const float z0 = __uint_as_float(zz << 16), z1 = __uint_as_float(zz & 0xffff0000u);
                *(unsigned*)(p.og + (grow0 + qrow) * D + hh * 128 + lane * 2) = pk_bf16(o0 * rstd * g0 * z0, o1 * rstd * g1 * z1);
            }
            __syncthreads();
        }
    }
}

__device__ __forceinline__ void grid_barrier(unsigned* ctr, unsigned target) {
    asm volatile("s_waitcnt vmcnt(0)" ::: "memory");
    __syncthreads();
    if (threadIdx.x == 0) {
        __builtin_amdgcn_fence(__ATOMIC_RELEASE, "agent");
        asm volatile("s_waitcnt vmcnt(0)" ::: "memory");
        __hip_atomic_fetch_add(ctr, 1u, __ATOMIC_RELAXED, __HIP_MEMORY_SCOPE_AGENT);
        while (__hip_atomic_load(ctr, __ATOMIC_RELAXED, __HIP_MEMORY_SCOPE_AGENT) < target) { }
        __builtin_amdgcn_fence(__ATOMIC_ACQUIRE, "agent");
        asm volatile("s_waitcnt vmcnt(0)" ::: "memory");
    }
    __syncthreads();
}

__device__ __forceinline__ void group_barrier(unsigned* bar, unsigned target) {
    grid_barrier(bar + 64 * (1 + (blockIdx.x & 7)), target);
}

__global__ void __launch_bounds__(NTHR, 2) fwd_kernel(Params p) {
    extern __shared__ __attribute__((aligned(16))) unsigned char smem[];
    cg::grid_group grid = cg::this_grid();
    if (blockIdx.x == 0 && threadIdx.x < 9) p.bar[64 * threadIdx.x] = 0u;
    phase0(p, smem);
    grid.sync();
    unsigned tgt = 0;
    const unsigned nb = gridDim.x >> 3;
    phase_prep(p, 0, 0);
    tgt += nb; group_barrier(p.bar, tgt);
#pragma unroll 1
    for (int l = 0; l < 4; ++l) {
        phase_inproj(p, l, smem);
        tgt += nb; group_barrier(p.bar, tgt);
        phase_attn(p, l, smem);
        tgt += nb; group_barrier(p.bar, tgt);
        const int nst = l < 3 ? 3 : 1;
#pragma unroll 1
        for (int st = 0; st < nst; ++st) {
            const bool do_out = st == 0 || (st == 1 && (blockIdx.x >> 3) < 4);
            if (do_out) phase_outproj(p, l, st == 1, smem);
            else phase_prep(p, l + 1, st);
            if (l < 3) { tgt += nb; group_barrier(p.bar, tgt); }
        }
    }
}

extern "C" void kernel_launch(void* const* d_in, const int* in_sizes, int n_in, void* d_out, int out_size, void* d_ws, size_t ws_size,
                              hipStream_t stream) {
    static int grid_blocks = 0;
    if (!grid_blocks) {
        int dev = 0, cus = 0;
        (void)hipGetDevice(&dev);
        (void)hipDeviceGetAttribute(&cus, hipDeviceAttributeMultiprocessorCount, dev);
        if (hipFuncSetAttribute((const void*)fwd_kernel, hipFuncAttributeMaxDynamicSharedMemorySize, LDS_BYTES) != hipSuccess)
            fprintf(stderr, "hipFuncSetAttribute(max dynamic LDS) failed\n");
        (void)hipGetLastError();
        grid_blocks = cus > 0 ? (cus & ~7) : 256;
    }
    Params p{};
    p.x = (const float*)d_in[0]; p.c = (const float*)d_in[1]; p.ctx = (const float*)d_in[2]; p.c_ctx = (const float*)d_in[3];
    p.norm_g = (const float*)d_in[4]; p.ada_w = (const float*)d_in[5]; p.ada_b = (const float*)d_in[6];
    const float* a_w_in = (const float*)d_in[7]; const float* a_q_g = (const float*)d_in[8]; const float* a_k_g = (const float*)d_in[9];
    const float* a_w_out = (const float*)d_in[10];
    const float* b_w_in = (const float*)d_in[11]; const float* b_q_g = (const float*)d_in[12]; const float* b_k_g = (const float*)d_in[13];
    const float* b_w_out = (const float*)d_in[15];
    const float* c_w_in = (const float*)d_in[16]; const float* c_q_g = (const float*)d_in[17]; const float* c_k_g = (const float*)d_in[18];
    const float* c_w_out = (const float*)d_in[24];
    p.w_in[0] = a_w_in; p.w_in[1] = b_w_in; p.w_in[2] = c_w_in; p.w_in[3] = a_w_in + (size_t)1024 * 2560;
    p.w_out[0] = a_w_out; p.w_out[1] = b_w_out; p.w_out[2] = c_w_out; p.w_out[3] = a_w_out + (size_t)1024 * 1024;
    p.q_g[0] = a_q_g; p.q_g[1] = b_q_g; p.q_g[2] = c_q_g; p.q_g[3] = a_q_g + 64;
    p.k_g[0] = a_k_g; p.k_g[1] = b_k_g; p.k_g[2] = c_k_g; p.k_g[3] = a_k_g + 64;
    p.rpb = (const float*)d_in[14];
    p.lq1 = (const float*)d_in[19]; p.lk1 = (const float*)d_in[20]; p.lq2 = (const float*)d_in[21]; p.lk2 = (const float*)d_in[22];
    p.subln_g = (const float*)d_in[23];
    p.out = (float*)d_out;
    char* ws = (char*)d_ws; size_t off = 0;
    auto take = [&](size_t bytes) { char* r = ws + off; off += (bytes + 255) & ~(size_t)255; return r; };
    p.xb = (float*)take((size_t)MCTX * D * 4);
    p.h = (bf16_t*)take((size_t)MTOT * D * 2);
    p.q = (bf16_t*)take((size_t)NB * 16 * TT * 64 * 2);
    p.k = (bf16_t*)take((size_t)NB * 16 * TT * 64 * 2);
    p.vt = (bf16_t*)take((size_t)NB * 1024 * TT * 2);
    p.sz = (bf16_t*)take((size_t)MTOT * D * 2);
    p.og = p.h;
    for (int l = 0; l < 4; ++l) { const int N = (l == 0 || l == 3) ? 2560 : 4096; p.wt_in[l] = (bf16_t*)take((size_t)N * 1024 * 2); }
    for (int l = 0; l < 4; ++l) p.wt_out[l] = (bf16_t*)take((size_t)1024 * 1024 * 2);
    p.mod = (float*)take((size_t)4 * 9 * 3072 * 4);
    p.rope = (float*)take(64 * 16 * 2 * 4);
    p.lam = (float*)take(256);
    p.bar = (unsigned*)take(4096);
    p.scr = (float*)take((size_t)256 * 2 * 256 * 128 * 4);
    if (off > ws_size) { fprintf(stderr, "workspace too small: need %zu have %zu\n", off, ws_size); return; }
    p.lam_init = (float)(0.8 - 0.6 * std::exp(-0.3 * 2.0));
    p.pad0 = 0.f;
    void* args[] = {&p};
    hipError_t e = hipLaunchCooperativeKernel((void*)fwd_kernel, dim3(grid_blocks), dim3(NTHR), args, LDS_BYTES, stream);
    if (e != hipSuccess) fprintf(stderr, "cooperative launch failed: %s (grid %d)\n", hipGetErrorString(e), grid_blocks);
}
```
